# Optimizing an MI355X kernel written in HIP

```python
import math
import jax, jax.numpy as jnp
from jax import lax
import numpy as np

D_MODEL = 1024
BATCH = 16
SEQ = 2048
DEPTH = 2

GRID_W = 64
CTX_LEN = 256
N_EVEN = (DEPTH + 1) // 2
N_ODD = DEPTH // 2
EPS = 1e-6

ROPE_HEAD_DIM = 64
ROPE_FREQS = ROPE_HEAD_DIM // 4
ROPE_BASE = 10000.0

SC_WIDTH = D_MODEL // 2
DA_HEADS = 4
DA_HEAD_DIM = ROPE_HEAD_DIM
DA_V_DIM = 2 * DA_HEAD_DIM
DA_QK_WIDTH = DA_HEADS * 2 * DA_HEAD_DIM
DA_WIDTH = DA_HEADS * DA_V_DIM
Q_BLOCK = 128
EVEN_SPLITS = (SC_WIDTH, 2 * SC_WIDTH, 3 * SC_WIDTH, 3 * SC_WIDTH + DA_QK_WIDTH, 3 * SC_WIDTH + 2 * DA_QK_WIDTH)
EVEN_IN = 3 * SC_WIDTH + 2 * DA_QK_WIDTH + DA_WIDTH
EVEN_OUT = SC_WIDTH + DA_WIDTH

POOL_WINDOWS = (2, 4, 8, 16)
POOL_RADII = tuple(w // 2 for w in POOL_WINDOWS)
POOL_GROUPS = 4
POOL_WIDTH = D_MODEL // 2
POOL_GROUP_DIM = POOL_WIDTH // POOL_GROUPS
RET_HEADS = 4
RET_QK_DIM = ROPE_HEAD_DIM
RET_V_DIM = 2 * RET_QK_DIM
RET_QK_WIDTH = RET_HEADS * RET_QK_DIM
RET_WIDTH = RET_HEADS * RET_V_DIM
RET_CHUNK = 128
ODD_SPLITS = (POOL_WIDTH, POOL_WIDTH + RET_QK_WIDTH, POOL_WIDTH + 2 * RET_QK_WIDTH, POOL_WIDTH + 2 * RET_QK_WIDTH + RET_WIDTH)
ODD_IN = POOL_WIDTH + 2 * RET_QK_WIDTH + 2 * RET_WIDTH
ODD_OUT = POOL_WIDTH + RET_WIDTH

FFN_DIM = 2816

kernel_name = 'hybrid_conv_diffattn_pool_retention_dit'


def rms_norm(x, g):
    xf = x.astype(jnp.float32)
    y = xf * lax.rsqrt(jnp.mean(xf * xf, axis=-1, keepdims=True) + EPS)
    return (y * g.astype(jnp.float32)).astype(x.dtype)


def modulate(h, shift, scale):
    return h * (1 + scale) + shift


def dwconv3(x, w):
    xp = jnp.pad(x, ((0, 0), (1, 1), (0, 0)))
    return xp[:, :-2] * w[0] + xp[:, 1:-1] * w[1] + xp[:, 2:] * w[2]


def rope_tables(rows):
    row = jnp.repeat(jnp.arange(rows, dtype=jnp.float32), GRID_W)
    col = jnp.tile(jnp.arange(GRID_W, dtype=jnp.float32), rows)
    inv = ROPE_BASE ** (-jnp.arange(ROPE_FREQS, dtype=jnp.float32) / ROPE_FREQS)
    ang = jnp.stack([row[:, None] * inv, col[:, None] * inv], axis=1)
    return jnp.cos(ang), jnp.sin(ang)


def apply_rope(x, cos, sin):
    shp = x.shape
    xr = x.reshape(*shp[:-1], 2, 2, ROPE_FREQS)
    bc = (shp[1],) + (1,) * (x.ndim - 3) + (2, ROPE_FREQS)
    c = cos.reshape(bc).astype(x.dtype)
    s = sin.reshape(bc).astype(x.dtype)
    x1, x2 = xr[..., 0, :], xr[..., 1, :]
    out = jnp.stack([x1 * c - x2 * s, x1 * s + x2 * c], axis=-2)
    return out.reshape(shp)


def conv_ffn(h, w_up, conv_w, conv_b, w_down):
    a, b = jnp.split(h @ w_up, 2, axis=-1)
    a = dwconv3(a, conv_w) + conv_b
    return (jax.nn.silu(a) * b) @ w_down


def diff_lambda_init(layer_idx):
    return 0.8 - 0.6 * math.exp(-0.3 * layer_idx)


def diff_attend(q, k, v, lam):
    s = jnp.einsum('bhmqd,bhmkd->bhmqk', q, k).astype(jnp.float32) * (DA_HEAD_DIM ** -0.5)
    p = jax.nn.softmax(s, axis=-1)
    p = p[:, :, 0] - lam * p[:, :, 1]
    return jnp.einsum('bhqk,bhkv->bhqv', p.astype(v.dtype), v)


def conv_diff_mixer(h_ctx, h_lat, w_in, w_out, sc_conv_w, q_g, k_g, lq1, lk1, lq2, lk2, subln_g, lam_init, cos, sin):
    f32 = jnp.float32
    lam = (jnp.exp(jnp.sum(lq1.astype(f32) * lk1.astype(f32)))
           - jnp.exp(jnp.sum(lq2.astype(f32) * lk2.astype(f32))) + lam_init)

    def project(h, rotate):
        b_g, c_g, xv, q, k, v = jnp.split(h @ w_in, EVEN_SPLITS, axis=-1)
        B_, N = h.shape[:2]
        q = rms_norm(q.reshape(B_, N, DA_HEADS, 2, DA_HEAD_DIM), q_g)
        k = rms_norm(k.reshape(B_, N, DA_HEADS, 2, DA_HEAD_DIM), k_g)
        if rotate:
            q = apply_rope(q, cos, sin)
            k = apply_rope(k, cos, sin)
        q = q.transpose(0, 2, 3, 1, 4)
        k = k.transpose(0, 2, 3, 1, 4)
        v = v.reshape(B_, N, DA_HEADS, DA_V_DIM).transpose(0, 2, 1, 3)
        return (b_g, c_g, xv), q, k, v

    def finish(gates, o):
        b_g, c_g, xv = gates
        y_conv = b_g * dwconv3(c_g * xv, sc_conv_w)
        B_, _, N, _ = o.shape
        o = rms_norm(o.transpose(0, 2, 1, 3), subln_g) * (1.0 - lam_init)
        return jnp.concatenate([y_conv, o.reshape(B_, N, DA_WIDTH).astype(y_conv.dtype)], axis=-1) @ w_out

    gates_c, qc, kc, vc = project(h_ctx, False)
    gates_l, ql, kl, vl = project(h_lat, True)
    k_all = jnp.concatenate([kl, kc], axis=3)
    v_all = jnp.concatenate([vl, vc], axis=2)
    B_, H, _, N, d = ql.shape
    nb = N // Q_BLOCK
    q_blocks = jnp.moveaxis(ql.reshape(B_, H, 2, nb, Q_BLOCK, d), 3, 0)
    o_blocks = lax.map(lambda qb: diff_attend(qb, k_all, v_all, lam), q_blocks)
    o_lat = jnp.moveaxis(o_blocks, 0, 2).reshape(B_, H, N, DA_V_DIM)
    y_lat = finish(gates_l, o_lat)
    y_ctx = finish(gates_c, diff_attend(qc, kc, vc, lam))
    return y_ctx, y_lat


def multiscale_pool(v, pool_w, pool_scale):
    B_, N, _ = v.shape
    vg = v.reshape(B_, N, POOL_GROUPS, POOL_GROUP_DIM).astype(jnp.float32)
    cs = jnp.concatenate([jnp.zeros_like(vg[:, :1]), jnp.cumsum(vg, axis=1)], axis=1)
    t = jnp.arange(N)[:, None]
    r = jnp.array(POOL_RADII)[None, :]
    lo = jnp.clip(t - r, 0, N)
    hi = jnp.clip(t + r + 1, 0, N)
    g = jnp.arange(POOL_GROUPS)[None, :]
    mean = (cs[:, hi, g] - cs[:, lo, g]) / (hi - lo).astype(jnp.float32)[:, :, None]
    y = (mean - vg).astype(v.dtype)
    y = jnp.einsum('bngc,gcd->bngd', y, pool_w)
    return y.reshape(B_, N, POOL_WIDTH) * pool_scale


def retention_scan(q, k, v, lg, s0):
    B_, H, N, _ = q.shape
    dv = v.shape[-1]
    nc = N // RET_CHUNK

    def chunks(t):
        return jnp.moveaxis(t.reshape(B_, H, nc, RET_CHUNK, t.shape[-1]), 2, 0)

    pos = jnp.arange(RET_CHUNK, dtype=jnp.float32)
    diff = pos[:, None] - pos[None, :]
    intra = jnp.where(diff >= 0, jnp.exp(lg[:, None, None] * jnp.maximum(diff, 0.0)), 0.0)
    q_dec = jnp.exp(lg[:, None] * (pos + 1.0))[None, :, :, None]
    k_dec = jnp.exp(lg[:, None] * (RET_CHUNK - 1.0 - pos))[None, :, :, None]
    c_dec = jnp.exp(lg * RET_CHUNK)[None, :, None, None]

    def step(s, qkv):
        qc, kc, vc = qkv
        att = jnp.einsum('bhid,bhjd->bhij', qc, kc) * intra
        o = jnp.einsum('bhij,bhjv->bhiv', att, vc) + jnp.einsum('bhid,bhdv->bhiv', qc * q_dec, s)
        s = s * c_dec + jnp.einsum('bhjd,bhjv->bhdv', kc * k_dec, vc)
        return s, o

    _, o = lax.scan(step, s0, (chunks(q), chunks(k), chunks(v)))
    return jnp.moveaxis(o, 0, 2).reshape(B_, H, N, dv)


def retention_bidir(q, k, v, lg_f, lg_b, s_f, s_b):
    o_f = retention_scan(q, k, v, lg_f, s_f)
    flip = lambda t: jnp.flip(t, axis=2)
    o_b = flip(retention_scan(flip(q), flip(k), flip(v), lg_b, s_b))
    return o_f + o_b


def context_states(k, v, lg_f, lg_b):
    L = k.shape[2]
    j = jnp.arange(L, dtype=jnp.float32)
    w_f = jnp.exp(lg_f[:, None] * (L - 1.0 - j))
    w_b = jnp.exp(lg_b[:, None] * j)
    s_f = jnp.einsum('bhjd,hj,bhjv->bhdv', k, w_f, v)
    s_b = jnp.einsum('bhjd,hj,bhjv->bhdv', k, w_b, v)
    return s_f, s_b


def pool_retention_mixer(h_ctx, h_lat, w_in, w_out, pool_w, pool_scale, dec_f, dec_b, gn_g, cos, sin, with_ctx):
    f32 = jnp.float32
    lg_f = -jnp.exp(dec_f.astype(f32))
    lg_b = -jnp.exp(dec_b.astype(f32))

    def heads(t, dh):
        B_, N = t.shape[:2]
        return t.reshape(B_, N, RET_HEADS, dh)

    def qkv_heads(q, k, v, rotate):
        q, k, v = heads(q, RET_QK_DIM), heads(k, RET_QK_DIM), heads(v, RET_V_DIM)
        if rotate:
            q = apply_rope(q, cos, sin)
            k = apply_rope(k, cos, sin)
        q = (q.astype(f32) * (RET_QK_DIM ** -0.5)).transpose(0, 2, 1, 3)
        k = k.astype(f32).transpose(0, 2, 1, 3)
        v = v.astype(f32).transpose(0, 2, 1, 3)
        return q, k, v

    def finish(pv, g, o):
        B_, _, N, _ = o.shape
        y_r = rms_norm(o.transpose(0, 2, 1, 3), gn_g).reshape(B_, N, RET_WIDTH).astype(g.dtype) * jax.nn.silu(g)
        y_p = multiscale_pool(pv, pool_w, pool_scale)
        return jnp.concatenate([y_p, y_r], axis=-1) @ w_out

    pv_l, q_l, k_l, v_l, g_l = jnp.split(h_lat @ w_in, ODD_SPLITS, axis=-1)
    ql, kl, vl = qkv_heads(q_l, k_l, v_l, True)
    if with_ctx:
        pv_c, q_c, k_c, v_c, g_c = jnp.split(h_ctx @ w_in, ODD_SPLITS, axis=-1)
        qc, kc, vc = qkv_heads(q_c, k_c, v_c, False)
    else:
        k_c, v_c = jnp.split(h_ctx @ w_in[:, ODD_SPLITS[1]:ODD_SPLITS[3]], [RET_QK_WIDTH], axis=-1)
        kc = heads(k_c, RET_QK_DIM).astype(f32).transpose(0, 2, 1, 3)
        vc = heads(v_c, RET_V_DIM).astype(f32).transpose(0, 2, 1, 3)
    s_f, s_b = context_states(kc, vc, lg_f, lg_b)
    y_lat = finish(pv_l, g_l, retention_bidir(ql, kl, vl, lg_f, lg_b, s_f, s_b))
    y_ctx = None
    if with_ctx:
        zero = jnp.zeros_like(s_f)
        y_ctx = finish(pv_c, g_c, retention_bidir(qc, kc, vc, lg_f, lg_b, zero, zero))
    return y_ctx, y_lat


def setup_inputs(seed: int = 0) -> dict:
    key = jax.random.key(seed)
    ks = iter(jax.random.split(key, 40))

    def nrm(shape, scale=1.0):
        return scale * jax.random.normal(next(ks), shape, jnp.float32)

    def gain(shape):
        return 1.0 + nrm(shape, 0.05)

    base_decay = jnp.log(-jnp.log1p(-(2.0 ** (-5.0 - jnp.arange(RET_HEADS, dtype=jnp.float32)))))
    return {
        'x': nrm((BATCH, SEQ, D_MODEL)),
        'c': nrm((BATCH, D_MODEL)),
        'ctx': nrm((BATCH, CTX_LEN, D_MODEL)),
        'c_ctx': nrm((D_MODEL,)),
        'mod_w': nrm((DEPTH, D_MODEL, 6 * D_MODEL), 0.5 * D_MODEL ** -0.5),
        'mod_b': nrm((DEPTH, 6 * D_MODEL), 0.01),
        'norm1_g': gain((DEPTH, D_MODEL)),
        'norm2_g': gain((DEPTH, D_MODEL)),
        'ev_w_in': nrm((N_EVEN, D_MODEL, EVEN_IN), D_MODEL ** -0.5),
        'ev_w_out': nrm((N_EVEN, EVEN_OUT, D_MODEL), EVEN_OUT ** -0.5),
        'sc_conv_w': nrm((N_EVEN, 3, SC_WIDTH), 3 ** -0.5),
        'da_q_norm': gain((N_EVEN, DA_HEAD_DIM)),
        'da_k_norm': gain((N_EVEN, DA_HEAD_DIM)),
        'da_lq1': nrm((N_EVEN, DA_HEAD_DIM), 0.1),
        'da_lk1': nrm((N_EVEN, DA_HEAD_DIM), 0.1),
        'da_lq2': nrm((N_EVEN, DA_HEAD_DIM), 0.1),
        'da_lk2': nrm((N_EVEN, DA_HEAD_DIM), 0.1),
        'da_subln_g': gain((N_EVEN, DA_V_DIM)),
        'od_w_in': nrm((N_ODD, D_MODEL, ODD_IN), D_MODEL ** -0.5),
        'od_w_out': nrm((N_ODD, ODD_OUT, D_MODEL), ODD_OUT ** -0.5),
        'pool_w': nrm((N_ODD, POOL_GROUPS, POOL_GROUP_DIM, POOL_GROUP_DIM), POOL_GROUP_DIM ** -0.5),
        'pool_scale': gain((N_ODD, POOL_WIDTH)),
        'ret_decay_f': base_decay + nrm((N_ODD, RET_HEADS), 0.1),
        'ret_decay_b': base_decay + nrm((N_ODD, RET_HEADS), 0.1),
        'ret_gn_g': gain((N_ODD, RET_V_DIM)),
        'ffn_w_up': nrm((DEPTH, D_MODEL, 2 * FFN_DIM), D_MODEL ** -0.5),
        'ffn_conv_w': nrm((DEPTH, 3, FFN_DIM), 3 ** -0.5),
        'ffn_conv_b': nrm((DEPTH, FFN_DIM), 0.01),
        'ffn_w_down': nrm((DEPTH, FFN_DIM, D_MODEL), FFN_DIM ** -0.5),
    }


def reference(x, c, ctx, c_ctx, mod_w, mod_b, norm1_g, norm2_g, ev_w_in, ev_w_out, sc_conv_w, da_q_norm, da_k_norm,
              da_lq1, da_lk1, da_lq2, da_lk2, da_subln_g, od_w_in, od_w_out, pool_w, pool_scale, ret_decay_f,
              ret_decay_b, ret_gn_g, ffn_w_up, ffn_conv_w, ffn_conv_b, ffn_w_down):
    ROWS = x.shape[1] // GRID_W
    cos, sin = rope_tables(ROWS)
    silu_c = jax.nn.silu(c)
    silu_cc = jax.nn.silu(c_ctx)
    for i in range(DEPTH):
        last = i == DEPTH - 1
        j = i // 2
        mod_l = (silu_c @ mod_w[i] + mod_b[i])[:, None, :]
        mod_c = silu_cc @ mod_w[i] + mod_b[i]
        sh1, sc1, g1, sh2, sc2, g2 = jnp.split(mod_l, 6, axis=-1)
        sh1c, sc1c, g1c, sh2c, sc2c, g2c = jnp.split(mod_c, 6, axis=-1)
        h_lat = modulate(rms_norm(x, norm1_g[i]), sh1, sc1)
        h_ctx = modulate(rms_norm(ctx, norm1_g[i]), sh1c, sc1c)
        if i % 2 == 0:
            y_ctx, y_lat = conv_diff_mixer(h_ctx, h_lat, ev_w_in[j], ev_w_out[j], sc_conv_w[j], da_q_norm[j],
                                           da_k_norm[j], da_lq1[j], da_lk1[j], da_lq2[j], da_lk2[j],
                                           da_subln_g[j], diff_lambda_init(i), cos, sin)
        else:
            y_ctx, y_lat = pool_retention_mixer(h_ctx, h_lat, od_w_in[j], od_w_out[j], pool_w[j], pool_scale[j],
                                                ret_decay_f[j], ret_decay_b[j], ret_gn_g[j], cos, sin, not last)
        x = x + g1 * y_lat
        x = x + g2 * conv_ffn(modulate(rms_norm(x, norm2_g[i]), sh2, sc2),
                              ffn_w_up[i], ffn_conv_w[i], ffn_conv_b[i], ffn_w_down[i])
        if not last:
            ctx = ctx + g1c * y_ctx
            ctx = ctx + g2c * conv_ffn(modulate(rms_norm(ctx, norm2_g[i]), sh2c, sc2c),
                                       ffn_w_up[i], ffn_conv_w[i], ffn_conv_b[i], ffn_w_down[i])
    return x
```

```cpp
#include <hip/hip_runtime.h>
#include <cstdio>
#include <cstdint>
namespace t1 {
constexpr int D = 1024, NB = 16, SEQ = 2048, CTX = 256, FFN = 2816;
__device__ __forceinline__ float silu_f(float v) { return v / (1.f + expf(-v)); }

__global__ void k_mod(const float* __restrict__ c, const float* __restrict__ c_ctx, const float* __restrict__ mod_w, const float* __restrict__ mod_b, float* __restrict__ MOD) {
    const int col = blockIdx.x * 256 + threadIdx.x, r = blockIdx.y, i = blockIdx.z;
    const float* cv = r < 16 ? c + r * 1024 : c_ctx;
    float acc = mod_b[i * 6144 + col];
    for (int k = 0; k < 1024; ++k) acc += silu_f(cv[k]) * mod_w[((size_t)i * 1024 + k) * 6144 + col];
    MOD[((size_t)i * 17 + r) * 6144 + col] = acc;
}
__global__ void k_norm_mod(const float* __restrict__ x, const float* __restrict__ g, const float* __restrict__ shift, const float* __restrict__ scale, float* __restrict__ out) {
    __shared__ float red[4];
    const int row = blockIdx.x, t = threadIdx.x;
    const float4 v = ((const float4*)(x + (size_t)row * D))[t];
    float s = v.x * v.x + v.y * v.y + v.z * v.z + v.w * v.w;
    for (int o = 32; o > 0; o >>= 1) s += __shfl_xor(s, o);
    if ((t & 63) == 0) red[t >> 6] = s;
    __syncthreads();
    s = red[0] + red[1] + red[2] + red[3];
    const float r = rsqrtf(s * (1.f / D) + 1e-6f);
    const float4 gg = ((const float4*)g)[t], sh = ((const float4*)shift)[t], sc = ((const float4*)scale)[t];
    float4 o;
    o.x = v.x * r * gg.x * (1.f + sc.x) + sh.x; o.y = v.y * r * gg.y * (1.f + sc.y) + sh.y;
    o.z = v.z * r * gg.z * (1.f + sc.z) + sh.z; o.w = v.w * r * gg.w * (1.f + sc.w) + sh.w;
    ((float4*)(out + (size_t)row * D))[t] = o;
}
__global__ void __launch_bounds__(256) k_gemm(const float* __restrict__ A, int lda, const float* __restrict__ B, int ldb, float* __restrict__ C, int ldc, int K) {
    __shared__ float As[16][68];
    __shared__ float Bs[16][68];
    const int tx = threadIdx.x & 15, ty = threadIdx.x >> 4;
    const int m0 = blockIdx.y * 64, n0 = blockIdx.x * 64;
    float acc[4][4];
#pragma unroll
    for (int i = 0; i < 4; ++i)
#pragma unroll
        for (int j = 0; j < 4; ++j) acc[i][j] = 0.f;
    const int ar = threadIdx.x >> 2, ac = (threadIdx.x & 3) * 4;
    const int br = threadIdx.x >> 4, bc = (threadIdx.x & 15) * 4;
    for (int k0 = 0; k0 < K; k0 += 16) {
        const float4 av = *(const float4*)(A + (size_t)(m0 + ar) * lda + k0 + ac);
        const float4 bv = *(const float4*)(B + (size_t)(k0 + br) * ldb + n0 + bc);
        __syncthreads();
        As[ac + 0][ar] = av.x; As[ac + 1][ar] = av.y; As[ac + 2][ar] = av.z; As[ac + 3][ar] = av.w;
        *(float4*)&Bs[br][bc] = bv;
        __syncthreads();
#pragma unroll
        for (int k = 0; k < 16; ++k) {
            const float4 a = *(const float4*)&As[k][ty * 4];
            const float4 b = *(const float4*)&Bs[k][tx * 4];
            const float aa[4] = {a.x, a.y, a.z, a.w}, bb[4] = {b.x, b.y, b.z, b.w};
#pragma unroll
            for (int i = 0; i < 4; ++i)
#pragma unroll
                for (int j = 0; j < 4; ++j) acc[i][j] += aa[i] * bb[j];
        }
    }
#pragma unroll
    for (int i = 0; i < 4; ++i) *(float4*)(C + (size_t)(m0 + ty * 4 + i) * ldc + n0 + tx * 4) = make_float4(acc[i][0], acc[i][1], acc[i][2], acc[i][3]);
}
__device__ __forceinline__ float rope_lane(float v, int d, int pos) {
    const int ax = d >> 5, half = (d >> 4) & 1, f = d & 15;
    const float inv = powf(10000.f, -(float)f / 16.f);
    const float ang = (float)(ax == 0 ? (pos >> 6) : (pos & 63)) * inv;
    const float cs = cosf(ang), sn = sinf(ang);
    const float other = __shfl_xor(v, 16);
    return half == 0 ? v * cs - other * sn : other * sn + v * cs;
}
__global__ void __launch_bounds__(64) k_qknorm_rope(float* __restrict__ P, int n, const float* __restrict__ qg, const float* __restrict__ kg, int rotate) {
    const int id = blockIdx.x, d = threadIdx.x;
    const int t = id >> 4, w = (id >> 3) & 1, hm = id & 7;
    float* p = P + (size_t)t * 3072 + 1536 + w * 512 + hm * 64;
    float v = p[d];
    float s = v * v;
    for (int o = 32; o > 0; o >>= 1) s += __shfl_xor(s, o);
    v = v * rsqrtf(s * (1.f / 64.f) + 1e-6f) * (w ? kg[d] : qg[d]);
    if (rotate) v = rope_lane(v, d, t);
    p[d] = v;
}
__global__ void __launch_bounds__(64) k_rope1(float* __restrict__ P, int n) {
    const int id = blockIdx.x, d = threadIdx.x;
    const int t = id >> 3, w = (id >> 2) & 1, h = id & 3;
    float* p = P + (size_t)t * 2048 + 512 + w * 256 + h * 64;
    const float v = rope_lane(p[d], d, t);
    p[d] = v * (w ? 1.f : 0.125f);
}
__global__ void __launch_bounds__(128) k_attn(const float* __restrict__ Pq, const float* __restrict__ Pk0, int nk0, const float* __restrict__ Pk1, int nk1, float lam_init,
                                              const float* __restrict__ lq1, const float* __restrict__ lk1, const float* __restrict__ lq2, const float* __restrict__ lk2, float* __restrict__ O) {
    __shared__ float Ks[16][128];
    __shared__ float Vs[16][128];
    const int h = blockIdx.y, ql = threadIdx.x & 63, q = blockIdx.x * 64 + ql, mp = threadIdx.x >> 6;
    float qv[64];
#pragma unroll
    for (int d = 0; d < 64; ++d) qv[d] = Pq[(size_t)q * 3072 + 1536 + h * 128 + mp * 64 + d];
    float acc[128];
#pragma unroll
    for (int d = 0; d < 128; ++d) acc[d] = 0.f;
    float m = -1e30f, l = 0.f;
    const int nk = nk0 + nk1;
    for (int j0 = 0; j0 < nk; j0 += 16) {
        __syncthreads();
        for (int e = threadIdx.x; e < 16 * 128; e += 128) {
            const int jj = e >> 7, d = e & 127, j = j0 + jj;
            const float* src = j < nk0 ? Pk0 + (size_t)j * 3072 : Pk1 + (size_t)(j - nk0) * 3072;
            Ks[jj][d] = src[2048 + h * 128 + d]; Vs[jj][d] = src[2560 + h * 128 + d];
        }
        __syncthreads();
        for (int jj = 0; jj < 16; ++jj) {
            float s = 0.f;
#pragma unroll
            for (int d = 0; d < 64; ++d) s += qv[d] * Ks[jj][mp * 64 + d];
            s *= 0.125f;
            const float mn = fmaxf(m, s), sc = expf(m - mn), p = expf(s - mn);
            l = l * sc + p; m = mn;
#pragma unroll
            for (int d = 0; d < 128; ++d) acc[d] = acc[d] * sc + p * Vs[jj][d];
        }
    }
    float a1 = 0.f, a2 = 0.f;
    for (int d = 0; d < 64; ++d) { a1 += lq1[d] * lk1[d]; a2 += lq2[d] * lk2[d]; }
    const float lam = expf(a1) - expf(a2) + lam_init;
    const float inv = 1.f / l;
    float* scr = &Ks[0][0];
#pragma unroll
    for (int part = 0; part < 4; ++part) {
        __syncthreads();
        if (mp == 1) {
#pragma unroll
            for (int d = 0; d < 32; ++d) scr[ql * 32 + d] = acc[part * 32 + d] * inv;
        }
        __syncthreads();
        if (mp == 0) {
#pragma unroll
            for (int d = 0; d < 32; ++d) O[(size_t)q * 512 + h * 128 + part * 32 + d] = acc[part * 32 + d] * inv - lam * scr[ql * 32 + d];
        }
    }
}
__global__ void __launch_bounds__(512) k_finish0(const float* __restrict__ P, const float* __restrict__ O, int n, const float* __restrict__ cw, const float* __restrict__ sg, float oscale, float* __restrict__ A2) {
    __shared__ float red[8];
    const int t = blockIdx.x, c = threadIdx.x;
    const float* p = P + (size_t)t * 3072;
    float u0 = 0.f, u2 = 0.f; const float u1 = p[512 + c] * p[1024 + c];
    if (t > 0) u0 = p[512 + c - 3072] * p[1024 + c - 3072];
    if (t + 1 < n) u2 = p[512 + c + 3072] * p[1024 + c + 3072];
    A2[(size_t)t * 1024 + c] = p[c] * (u0 * cw[c] + u1 * cw[512 + c] + u2 * cw[1024 + c]);
    const float o = O[(size_t)t * 512 + c];
    float s = o * o;
    for (int k = 32; k > 0; k >>= 1) s += __shfl_xor(s, k);
    if ((c & 63) == 0) red[c >> 6] = s;
    __syncthreads();
    const int h = c >> 7;
    s = red[2 * h] + red[2 * h + 1];
    A2[(size_t)t * 1024 + 512 + c] = o * rsqrtf(s * (1.f / 128.f) + 1e-6f) * sg[c & 127] * oscale;
}
__global__ void k_resid(const float* __restrict__ xin, const float* __restrict__ g, const float* __restrict__ Y, float* __restrict__ xout, int n) {
    const size_t id = (size_t)blockIdx.x * blockDim.x + threadIdx.x;
    if (id >= (size_t)n * 1024) return;
    xout[id] = xin[id] + g[id & 1023] * Y[id];
}
__global__ void k_ffn_act(const float* __restrict__ UP, int n, const float* __restrict__ cw, const float* __restrict__ cb, float* __restrict__ HACT) {
    const size_t id = (size_t)blockIdx.x * blockDim.x + threadIdx.x;
    if (id >= (size_t)n * FFN) return;
    const int t = (int)(id / FFN), c = (int)(id % FFN);
    const float* u = UP + (size_t)t * 5632 + c;
    float a = u[0] * cw[FFN + c] + cb[c];
    if (t > 0) a += u[-5632] * cw[c];
    if (t + 1 < n) a += u[5632] * cw[2 * FFN + c];
    HACT[id] = silu_f(a) * u[FFN];
}
__global__ void __launch_bounds__(64) k_ret(const float* __restrict__ P, const float* __restrict__ PC, const float* __restrict__ dec_f, const float* __restrict__ dec_b, float* __restrict__ O) {
    __shared__ float Ks[16][64];
    __shared__ float Vs[16][128];
    const int h = blockIdx.y, i = blockIdx.x * 64 + threadIdx.x;
    const float lgf = -expf(dec_f[h]), lgb = -expf(dec_b[h]);
    float qv[64];
#pragma unroll
    for (int d = 0; d < 64; ++d) qv[d] = P[(size_t)i * 2048 + 512 + h * 64 + d];
    float acc[128];
#pragma unroll
    for (int d = 0; d < 128; ++d) acc[d] = 0.f;
    for (int j0 = 0; j0 < 2048 + 256; j0 += 16) {
        __syncthreads();
        for (int e = threadIdx.x; e < 16 * 64; e += 64) { const int jj = e >> 6, d = e & 63, j = j0 + jj; Ks[jj][d] = j < 2048 ? P[(size_t)j * 2048 + 768 + h * 64 + d] : PC[(size_t)(j - 2048) * 768 + h * 64 + d]; }
        for (int e = threadIdx.x; e < 16 * 128; e += 64) { const int jj = e >> 7, d = e & 127, j = j0 + jj; Vs[jj][d] = j < 2048 ? P[(size_t)j * 2048 + 1024 + h * 128 + d] : PC[(size_t)(j - 2048) * 768 + 256 + h * 128 + d]; }
        __syncthreads();
        for (int jj = 0; jj < 16; ++jj) {
            const int j = j0 + jj;
            float w;
            if (j < 2048) { w = 0.f; if (j <= i) w += expf(lgf * (float)(i - j)); if (j >= i) w += expf(lgb * (float)(j - i)); }
            else { const int jc = j - 2048; w = expf(lgf * (float)(i + 256 - jc)) + expf(lgb * (float)(2048 + jc - i)); }
            float s = 0.f;
#pragma unroll
            for (int d = 0; d < 64; ++d) s += qv[d] * Ks[jj][d];
            s *= w;
#pragma unroll
            for (int d = 0; d < 128; ++d) acc[d] += s * Vs[jj][d];
        }
    }
#pragma unroll
    for (int d = 0; d < 128; ++d) O[(size_t)i * 512 + h * 128 + d] = acc[d];
}
__global__ void k_poolmean(const float* __restrict__ P, int n, float* __restrict__ PM) {
    const int id = blockIdx.x * blockDim.x + threadIdx.x;
    if (id >= n * 512) return;
    const int t = id >> 9, c = id & 511, g = c >> 7, r = 1 << g;
    const int lo = max(t - r, 0), hi = min(t + r + 1, n);
    float s = 0.f;
    for (int j = lo; j < hi; ++j) s += P[(size_t)j * 2048 + c];
    PM[id] = s / (float)(hi - lo) - P[(size_t)t * 2048 + c];
}
__global__ void __launch_bounds__(512) k_finish1(const float* __restrict__ P, const float* __restrict__ O, const float* __restrict__ YP, const float* __restrict__ ps, const float* __restrict__ gn, float* __restrict__ A6) {
    __shared__ float red[8];
    const int t = blockIdx.x, c = threadIdx.x;
    A6[(size_t)t * 1024 + c] = YP[(size_t)t * 512 + c] * ps[c];
    const float o = O[(size_t)t * 512 + c];
    float s = o * o;
    for (int k = 32; k > 0; k >>= 1) s += __shfl_xor(s, k);
    if ((c & 63) == 0) red[c >> 6] = s;
    __syncthreads();
    const int h = c >> 7;
    s = red[2 * h] + red[2 * h + 1];
    A6[(size_t)t * 1024 + 512 + c] = o * rsqrtf(s * (1.f / 128.f) + 1e-6f) * gn[c & 127] * silu_f(P[(size_t)t * 2048 + 1536 + c]);
}

struct In { const float* p[29]; };
struct Ws {
    float *MOD, *XC, *HL, *HC, *PL, *PC, *OL, *OC, *A2L, *A2C, *YL, *YC, *UP, *HACT, *PM, *YP;
};
inline Ws carve(float* base) {
    Ws w; size_t o = 0;
    auto take = [&](size_t n) { float* p = base + o; o += (n + 63) & ~(size_t)63; return p; };
    w.MOD = take((size_t)2 * 17 * 6144);
    w.XC = take((size_t)NB * CTX * D);
    w.HL = take((size_t)SEQ * D); w.HC = take((size_t)CTX * D);
    w.PL = take((size_t)SEQ * 3072); w.PC = take((size_t)CTX * 3072);
    w.OL = take((size_t)SEQ * 512); w.OC = take((size_t)CTX * 512);
    w.A2L = take((size_t)SEQ * D); w.A2C = take((size_t)CTX * D);
    w.YL = take((size_t)SEQ * D); w.YC = take((size_t)CTX * D);
    w.UP = take((size_t)SEQ * 5632); w.HACT = take((size_t)SEQ * FFN);
    w.PM = take((size_t)SEQ * 512); w.YP = take((size_t)SEQ * 512);
    return w;
}
inline void gemm(hipStream_t s, const float* A, int lda, const float* B, int ldb, float* C, int ldc, int M, int N, int K) {
    hipLaunchKernelGGL(k_gemm, dim3(N / 64, M / 64), dim3(256), 0, s, A, lda, B, ldb, C, ldc, K);
}
inline void ffn(hipStream_t s, const In& in, const Ws& w, int layer, float* X, int n, const float* mod  , float* H, float* Y) {
    hipLaunchKernelGGL(k_norm_mod, dim3(n), dim3(256), 0, s, X, in.p[7] + layer * 1024, mod + 3 * 1024, mod + 4 * 1024, H);
    gemm(s, H, 1024, in.p[25] + (size_t)layer * 1024 * 5632, 5632, w.UP, 5632, n, 5632, 1024);
    hipLaunchKernelGGL(k_ffn_act, dim3((unsigned)(((size_t)n * FFN + 255) / 256)), dim3(256), 0, s, w.UP, n, in.p[26] + (size_t)layer * 3 * FFN, in.p[27] + (size_t)layer * FFN, w.HACT);
    gemm(s, w.HACT, FFN, in.p[28] + (size_t)layer * FFN * 1024, 1024, Y, 1024, n, 1024, FFN);
    hipLaunchKernelGGL(k_resid, dim3(n * 1024 / 256), dim3(256), 0, s, X, mod + 5 * 1024, Y, X, n);
}
inline void forward(hipStream_t s, const In& in, float* out, float* wsf, int b0, int b1) {
    const Ws w = carve(wsf);
    hipLaunchKernelGGL(k_mod, dim3(24, 17, 2), dim3(256), 0, s, in.p[1], in.p[3], in.p[4], in.p[5], w.MOD);
    hipMemcpyAsync(out + (size_t)b0 * SEQ * D, in.p[0] + (size_t)b0 * SEQ * D, (size_t)(b1 - b0) * SEQ * D * 4, hipMemcpyDeviceToDevice, s);
    hipMemcpyAsync(w.XC + (size_t)b0 * CTX * D, in.p[2] + (size_t)b0 * CTX * D, (size_t)(b1 - b0) * CTX * D * 4, hipMemcpyDeviceToDevice, s);
    for (int b = b0; b < b1; ++b) {
        float* XL = out + (size_t)b * SEQ * D; float* XCb = w.XC + (size_t)b * CTX * D;
        const float* ml = w.MOD + ((size_t)0 * 17 + b) * 6144; const float* mc = w.MOD + ((size_t)0 * 17 + 16) * 6144;
        hipLaunchKernelGGL(k_norm_mod, dim3(SEQ), dim3(256), 0, s, XL, in.p[6], ml, ml + 1024, w.HL);
        hipLaunchKernelGGL(k_norm_mod, dim3(CTX), dim3(256), 0, s, XCb, in.p[6], mc, mc + 1024, w.HC);
        gemm(s, w.HL, 1024, in.p[8], 3072, w.PL, 3072, SEQ, 3072, 1024);
        gemm(s, w.HC, 1024, in.p[8], 3072, w.PC, 3072, CTX, 3072, 1024);
        hipLaunchKernelGGL(k_qknorm_rope, dim3(SEQ * 16), dim3(64), 0, s, w.PL, SEQ, in.p[11], in.p[12], 1);
        hipLaunchKernelGGL(k_qknorm_rope, dim3(CTX * 16), dim3(64), 0, s, w.PC, CTX, in.p[11], in.p[12], 0);
        hipLaunchKernelGGL(k_attn, dim3(SEQ / 64, 4), dim3(128), 0, s, w.PL, w.PL, SEQ, w.PC, CTX, 0.2f, in.p[13], in.p[14], in.p[15], in.p[16], w.OL);
        hipLaunchKernelGGL(k_attn, dim3(CTX / 64, 4), dim3(128), 0, s, w.PC, w.PC, CTX, w.PC, 0, 0.2f, in.p[13], in.p[14], in.p[15], in.p[16], w.OC);
        hipLaunchKernelGGL(k_finish0, dim3(SEQ), dim3(512), 0, s, w.PL, w.OL, SEQ, in.p[10], in.p[17], 0.8f, w.A2L);
        hipLaunchKernelGGL(k_finish0, dim3(CTX), dim3(512), 0, s, w.PC, w.OC, CTX, in.p[10], in.p[17], 0.8f, w.A2C);
        gemm(s, w.A2L, 1024, in.p[9], 1024, w.YL, 1024, SEQ, 1024, 1024);
        gemm(s, w.A2C, 1024, in.p[9], 1024, w.YC, 1024, CTX, 1024, 1024);
        hipLaunchKernelGGL(k_resid, dim3(SEQ * 1024 / 256), dim3(256), 0, s, XL, ml + 2 * 1024, w.YL, XL, SEQ);
        hipLaunchKernelGGL(k_resid, dim3(CTX * 1024 / 256), dim3(256), 0, s, XCb, mc + 2 * 1024, w.YC, XCb, CTX);
        ffn(s, in, w, 0, XL, SEQ, ml, w.HL, w.YL);
        ffn(s, in, w, 0, XCb, CTX, mc, w.HC, w.YC);
        ml = w.MOD + ((size_t)1 * 17 + b) * 6144; mc = w.MOD + ((size_t)1 * 17 + 16) * 6144;
        hipLaunchKernelGGL(k_norm_mod, dim3(SEQ), dim3(256), 0, s, XL, in.p[6] + 1024, ml, ml + 1024, w.HL);
        hipLaunchKernelGGL(k_norm_mod, dim3(CTX), dim3(256), 0, s, XCb, in.p[6] + 1024, mc, mc + 1024, w.HC);
        gemm(s, w.HL, 1024, in.p[18], 2048, w.PL, 2048, SEQ, 2048, 1024);
        gemm(s, w.HC, 1024, in.p[18] + 768, 2048, w.PC, 768, CTX, 768, 1024);
        hipLaunchKernelGGL(k_rope1, dim3(SEQ * 8), dim3(64), 0, s, w.PL, SEQ);
        hipLaunchKernelGGL(k_ret, dim3(SEQ / 64, 4), dim3(64), 0, s, w.PL, w.PC, in.p[22], in.p[23], w.OL);
        hipLaunchKernelGGL(k_poolmean, dim3(SEQ * 512 / 256), dim3(256), 0, s, w.PL, SEQ, w.PM);
        for (int g = 0; g < 4; ++g) gemm(s, w.PM + g * 128, 512, in.p[20] + (size_t)g * 128 * 128, 128, w.YP + g * 128, 512, SEQ, 128, 128);
        hipLaunchKernelGGL(k_finish1, dim3(SEQ), dim3(512), 0, s, w.PL, w.OL, w.YP, in.p[21], in.p[24], w.A2L);
        gemm(s, w.A2L, 1024, in.p[19], 1024, w.YL, 1024, SEQ, 1024, 1024);
        hipLaunchKernelGGL(k_resid, dim3(SEQ * 1024 / 256), dim3(256), 0, s, XL, ml + 2 * 1024, w.YL, XL, SEQ);
        ffn(s, in, w, 1, XL, SEQ, ml, w.HL, w.YL);
    }
}
}
extern "C" void kernel_launch(void* const* d_in, const int* in_sizes, int n_in, void* d_out, int out_size, void* d_ws, size_t ws_size, hipStream_t stream) {
    t1::In in; for (int i = 0; i < 29; ++i) in.p[i] = (const float*)d_in[i];
    t1::forward(stream, in, (float*)d_out, (float*)d_ws, 0, 16);
}
```

```cpp
#include <hip/hip_runtime.h>
#include <cstdio>
#include <cstdint>
#include <cstring>
#define LAS __attribute__((address_space(3)))
#define GAS __attribute__((address_space(1)))
typedef unsigned short bf16_t;
typedef short bf16x8 __attribute__((ext_vector_type(8)));
typedef short s16x4 __attribute__((ext_vector_type(4)));
typedef float f32x4 __attribute__((ext_vector_type(4)));
typedef float f32x16 __attribute__((ext_vector_type(16)));
typedef unsigned u32x4 __attribute__((ext_vector_type(4)));
typedef unsigned u32x2 __attribute__((ext_vector_type(2)));
typedef GAS unsigned gu32;

__device__ __forceinline__ unsigned cvt_pk_bf16(float lo, float hi) { unsigned r; asm volatile("v_cvt_pk_bf16_f32 %0, %1, %2" : "=v"(r) : "v"(lo), "v"(hi)); return r; }
__device__ __forceinline__ float bf_lo(unsigned u) { return __uint_as_float(u << 16); }
__device__ __forceinline__ float bf_hi(unsigned u) { return __uint_as_float(u & 0xffff0000u); }
__device__ __forceinline__ float fast_silu(float v) { return v * __builtin_amdgcn_rcpf(1.f + __builtin_amdgcn_exp2f(-1.4426950408889634f * v)); }
__device__ __forceinline__ float wave_sum(float v) {
#pragma unroll
    for (int o = 1; o < 64; o <<= 1) v += __shfl_xor(v, o);
    return v;
}
__device__ __forceinline__ float wave_max(float v) {
#pragma unroll
    for (int o = 1; o < 64; o <<= 1) v = fmaxf(v, __shfl_xor(v, o));
    return v;
}
__device__ __forceinline__ void glds16(const void* gsrc, unsigned lds_dst) {
    unsigned keep;
    asm volatile("s_mov_b32 %0, m0\n\ts_mov_b32 m0, %2\n\ts_nop 0\n\tglobal_load_lds_dwordx4 %1, off\n\ts_mov_b32 m0, %0" : "=&s"(keep) : "v"(gsrc), "s"(lds_dst) : "memory");
}
#define WAIT_BAR(N) asm volatile("s_waitcnt vmcnt(" #N ") lgkmcnt(0)\n\ts_barrier" ::: "memory")
typedef short v4i16_t __attribute__((ext_vector_type(4)));
__device__ __forceinline__ s16x4 tr_read(const LAS char* p) { return __builtin_bit_cast(s16x4, __builtin_amdgcn_ds_read_tr16_b64_v4i16((LAS v4i16_t*)p)); }
__device__ __forceinline__ bf16x8 cat8(s16x4 lo, s16x4 hi) { return (bf16x8){lo[0], lo[1], lo[2], lo[3], hi[0], hi[1], hi[2], hi[3]}; }
__device__ __forceinline__ int crow(int r, int hi) { return (r & 3) + 8 * (r >> 2) + 4 * hi; }

namespace pg8 {
constexpr int BM = 256, BK = 64, HALF = 128, HTB = HALF * BK * 2  , STAGE_BYTES = 8 * HTB, NXCD = 8, WGM = 8;
__host__ __device__ __forceinline__ int lds_byte(int r, int c) { const int st = (r >> 4) * 2 + (c >> 5), rr = r & 15, cc = c & 31, ob = rr * 64 + cc * 2; return st * 1024 + (ob ^ (((ob >> 9) & 1) << 5)); }
__host__ __device__ __forceinline__ void stage_rc(int b, int& R, int& C) { const int st = b / 1024, sb = b % 1024, swz = sb ^ (((sb >> 9) & 1) << 5); R = (st >> 1) * 16 + swz / 64; C = (st & 1) * 32 + (swz % 64) / 2; }

struct Unit { int pm, pn; };
struct Gemm { const bf16_t* A; const bf16_t* Bt; int K; long a_tstep; };

struct StaticOrder {
    int nM, nN, nwg, G, c;
    __device__ void init(int nM_, int nN_, int G_, int c_) { nM = nM_; nN = nN_; nwg = nM * nN; G = G_; c = c_; }
    __device__ bool next(int i, Unit& u) const {
        const long L = (long)i * G + c; if (L >= nwg) return false;
        int wgid = (int)L; { const int q = nwg / NXCD, r = nwg % NXCD, xcd = wgid % NXCD, off = wgid / NXCD; wgid = (xcd < r ? xcd * (q + 1) : r * (q + 1) + (xcd - r) * q) + off; }
        const int nig = WGM * nN, gid = wgid / nig, fm = gid * WGM, gsz = (nM - fm) < WGM ? (nM - fm) : WGM;
        u.pm = fm + ((wgid % nig) % gsz); u.pn = (wgid % nig) / gsz; return true;
    }
};

template <class Epi, class Sched>
__device__ __forceinline__ void gemm_phase(LAS unsigned char* lds, const Gemm g, const Sched& S, const Epi& E) {
    const int tid = threadIdx.x, wid = __builtin_amdgcn_readfirstlane(tid >> 6), lane = tid & 63, wr = wid >> 2, wc = wid & 3, fr = lane & 15, fq = lane >> 4;
    const int K = g.K, nt = K / BK;
    unsigned voffA[2];
#pragma unroll
    for (int i = 0; i < 2; ++i) { int R, C; stage_rc(tid * 16 + i * 8192, R, C); voffA[i] = (unsigned)(R * K + C) * 2u; }
    const size_t kstep = (size_t)(BK * 2);
    const size_t hstep = (size_t)HALF * K * 2;
    const size_t btstep = 2 * hstep;
    const unsigned ldsw = (unsigned)wid * 1024u;
    const int aoff = lds_byte(wr * 64 + fr, fq * 8), boff = lds_byte(wc * 32 + fr, fq * 8);
#define PG8_SA(b, h) (((b) * 2 + (h)) * HTB)
#define PG8_SB(b, h) ((4 + (b) * 2 + (h)) * HTB)
#define PG8_STAGE(bufoff, gbase) do { _Pragma("unroll") for (int _i = 0; _i < 2; ++_i) \
        __builtin_amdgcn_global_load_lds((const unsigned*)((const char*)(gbase) + voffA[_i]), (LAS unsigned*)(lds + (bufoff) + ldsw + _i * 8192), 16, 0, 0); } while (0)
#define PG8_LDA(dst, b, h) do { _Pragma("unroll") for (int m = 0; m < 4; ++m) _Pragma("unroll") for (int k = 0; k < 2; ++k) dst[m][k] = *(const LAS bf16x8*)(lds + PG8_SA(b, h) + aoff + m * 2048 + k * 1024); } while (0)
#define PG8_LDB(dst, b, h) do { _Pragma("unroll") for (int n = 0; n < 2; ++n) _Pragma("unroll") for (int k = 0; k < 2; ++k) dst[n][k] = *(const LAS bf16x8*)(lds + PG8_SB(b, h) + boff + n * 2048 + k * 1024); } while (0)
#define PG8_MMA(ai, bj, At, Bt) do { __builtin_amdgcn_s_setprio(1); _Pragma("unroll") for (int m = 0; m < 4; ++m) _Pragma("unroll") for (int n = 0; n < 2; ++n) _Pragma("unroll") for (int k = 0; k < 2; ++k) \
        acc[ai][bj][m][n] = __builtin_amdgcn_mfma_f32_16x16x32_bf16(Bt[n][k], At[m][k], acc[ai][bj][m][n], 0, 0, 0); __builtin_amdgcn_s_setprio(0); } while (0)
#define PG8_WAIT_V(n) asm volatile("s_waitcnt vmcnt(" #n ")" ::: "memory")
#define PG8_WAIT_L(n) asm volatile("s_waitcnt lgkmcnt(" #n ")" ::: "memory")
#define PG8_BAR __builtin_amdgcn_s_barrier()
#define PG8_SCHED __builtin_amdgcn_sched_barrier(0)
    Unit cur, nxt; int ui = 0;
    if (!S.next(0, cur)) return;
    f32x4 acc[2][2][4][2];
#pragma unroll
    for (int a = 0; a < 2; ++a)
#pragma unroll
        for (int b = 0; b < 2; ++b)
#pragma unroll
            for (int m = 0; m < 4; ++m)
#pragma unroll
                for (int n = 0; n < 2; ++n) acc[a][b][m][n] = (f32x4){0.f, 0.f, 0.f, 0.f};
    bf16x8 At[4][2], B0[2][2], B1[2][2];
    const char* cA = (const char*)g.A + (long)cur.pm * g.a_tstep; const char* cB = (const char*)g.Bt + (size_t)cur.pn * btstep;
    PG8_STAGE(PG8_SB(0, 0), cB); PG8_STAGE(PG8_SB(0, 1), cB + hstep); PG8_STAGE(PG8_SA(0, 0), cA); PG8_STAGE(PG8_SA(0, 1), cA + hstep);
    if (wr == 1) PG8_BAR;
    PG8_WAIT_V(2); PG8_BAR;
    PG8_STAGE(PG8_SB(1, 0), cB + kstep); PG8_STAGE(PG8_SA(1, 0), cA + kstep); PG8_STAGE(PG8_SB(1, 1), cB + hstep + kstep);
    PG8_WAIT_V(6); PG8_BAR;
    for (;;) {
        const bool has_next = S.next(ui + 1, nxt);
        const char* nA = has_next ? (const char*)g.A + (long)nxt.pm * g.a_tstep : cA; const char* nB = has_next ? (const char*)g.Bt + (size_t)nxt.pn * btstep : cB;
        for (int t = 0; t < nt; t += 2) {
            const bool last = (t == nt - 2);
            const char* a1 = cA + (size_t)(t + 1) * kstep;
            const char* a2 = last ? nA : cA + (size_t)(t + 2) * kstep; const char* b2 = last ? nB : cB + (size_t)(t + 2) * kstep;
            const char* a3 = a2 + kstep; const char* b3 = b2 + kstep;
            PG8_LDB(B0, 0, 0); PG8_LDB(B1, 0, 1); PG8_SCHED; PG8_LDA(At, 0, 0); PG8_STAGE(PG8_SA(1, 1), a1 + hstep);
            PG8_WAIT_V(8); PG8_WAIT_L(0); PG8_BAR; PG8_MMA(0, 0, At, B0); PG8_MMA(0, 1, At, B1); PG8_BAR; PG8_SCHED;
            PG8_LDA(At, 0, 1); PG8_STAGE(PG8_SB(0, 0), b2); PG8_STAGE(PG8_SB(0, 1), b2 + hstep); PG8_STAGE(PG8_SA(0, 0), a2);
            PG8_WAIT_V(8); PG8_WAIT_L(0); PG8_BAR; PG8_MMA(1, 0, At, B0); PG8_MMA(1, 1, At, B1); PG8_BAR; PG8_SCHED;
            PG8_LDB(B0, 1, 0); PG8_LDB(B1, 1, 1); PG8_SCHED; PG8_LDA(At, 1, 0); PG8_STAGE(PG8_SA(0, 1), a2 + hstep);
            PG8_WAIT_V(8); PG8_WAIT_L(0); PG8_BAR; PG8_MMA(0, 0, At, B0); PG8_MMA(0, 1, At, B1); PG8_BAR; PG8_SCHED;
            PG8_LDA(At, 1, 1); PG8_STAGE(PG8_SB(1, 0), b3); PG8_STAGE(PG8_SB(1, 1), b3 + hstep); PG8_STAGE(PG8_SA(1, 0), a3);
            PG8_WAIT_V(8); PG8_WAIT_L(0); PG8_BAR; PG8_MMA(1, 0, At, B0); PG8_MMA(1, 1, At, B1); PG8_BAR; PG8_SCHED;
        }
        if (wr == 0) PG8_BAR;
        E(acc, cur, wr, wc, fr, fq);
        if (!has_next) break;
#pragma unroll
        for (int a = 0; a < 2; ++a)
#pragma unroll
            for (int b = 0; b < 2; ++b)
#pragma unroll
                for (int m = 0; m < 4; ++m)
#pragma unroll
                    for (int n = 0; n < 2; ++n) acc[a][b][m][n] = (f32x4){0.f, 0.f, 0.f, 0.f};
        cur = nxt; cA = nA; cB = nB; ++ui;
        if (wr == 1) PG8_BAR;
    }
    PG8_WAIT_V(0);
    PG8_BAR;
#undef PG8_SA
#undef PG8_SB
#undef PG8_STAGE
#undef PG8_LDA
#undef PG8_LDB
#undef PG8_MMA
#undef PG8_WAIT_V
#undef PG8_WAIT_L
#undef PG8_BAR
#undef PG8_SCHED
}
}

#define XB_TMO      128
#define XB_XCNT(j)  (256  + 64 * (j))
#define XB_XSUB(j)  (1280 + 64 * (j))
#define XB_XGEN(j)  (2304 + 64 * (j))
#define XB_TOP      3328
#define XB_TOPGEN   3392
#define XCD_BAR_WORDS 3456
#define XB_SPIN_CAP (1u << 18)
__device__ __forceinline__ unsigned xb_ld(unsigned* p)              { return __hip_atomic_load(p, __ATOMIC_RELAXED, __HIP_MEMORY_SCOPE_AGENT); }
__device__ __forceinline__ unsigned xb_add(unsigned* p, unsigned v) { return __hip_atomic_fetch_add(p, v, __ATOMIC_RELAXED, __HIP_MEMORY_SCOPE_AGENT); }
__device__ __forceinline__ unsigned xb_xcc_id() { return (unsigned)__builtin_amdgcn_s_getreg((3 << 11) | 20) & 0xFu; }
#define XB_SPIN(cond, bar) do { unsigned _sp = 0; while (cond) { __builtin_amdgcn_s_sleep(1); \
    if ((++_sp & 255u) == 0u) { if (xb_ld(&(bar)[XB_TMO])) break; if (_sp > XB_SPIN_CAP) { atomicAdd(&(bar)[XB_TMO], 1u); break; } } } } while (0)
struct XcdBarrier { unsigned* bar; unsigned x; volatile LAS unsigned* st; };
__device__ __forceinline__ XcdBarrier xcd_barrier_post(unsigned* bar, volatile LAS unsigned* st) {
    XcdBarrier b; b.bar = bar; b.x = xb_xcc_id(); b.st = st;
    if (threadIdx.x == 0) (void)xb_add(&bar[XB_XCNT(b.x)], 1u);
    return b;
}
__device__ __forceinline__ void xcd_barrier_complete(unsigned* bar, unsigned x, unsigned& nloc, unsigned& nx) {
    const unsigned G = gridDim.x * gridDim.y * gridDim.z;
    unsigned sum, cnt, mine, sp = 0u;
    for (;;) {
        sum = 0u; cnt = 0u; mine = 0u;
#pragma unroll
        for (unsigned j = 0; j < 16; ++j) { const unsigned c = xb_ld(&bar[XB_XCNT(j)]); sum += c; cnt += (c > 0u) ? 1u : 0u; mine = (j == x) ? c : mine; }
        if (sum == G) break;
        __builtin_amdgcn_s_sleep(1);
        if ((++sp & 255u) == 0u) { if (xb_ld(&bar[XB_TMO])) break; if (sp > XB_SPIN_CAP) { atomicAdd(&bar[XB_TMO], 1u); break; } }
    }
    nloc = mine > 0u ? mine : 1u; nx = cnt > 0u ? cnt : 1u;
}
__device__ __forceinline__ void xcd_barrier(const XcdBarrier& b) {
    asm volatile("s_waitcnt vmcnt(0)" ::: "memory");
    __syncthreads();
    if (threadIdx.x == 0) {
        unsigned* bar = b.bar;
        __builtin_amdgcn_s_waitcnt(0);
        unsigned nloc = b.st[0], nx = b.st[1];
        if (nloc == 0u) { xcd_barrier_complete(bar, b.x, nloc, nx); b.st[0] = nloc; b.st[1] = nx; }
        const unsigned old = xb_add(&bar[XB_XSUB(b.x)], 1u);
        const unsigned gen = old / nloc;
        if (old + 1u == (gen + 1u) * nloc) {
            __builtin_amdgcn_fence(__ATOMIC_RELEASE, "agent");
            asm volatile("s_waitcnt vmcnt(0)" ::: "memory");
            const unsigned og = xb_add(&bar[XB_TOP], 1u);
            const unsigned tg = og / nx;
            if (og + 1u == (tg + 1u) * nx) xb_add(&bar[XB_TOPGEN], 1u);
            else XB_SPIN(xb_ld(&bar[XB_TOPGEN]) == tg, bar);
            __builtin_amdgcn_fence(__ATOMIC_ACQUIRE, "agent");
            xb_add(&bar[XB_XGEN(b.x)], 1u);
            asm volatile("s_waitcnt vmcnt(0)" ::: "memory");
        } else {
            XB_SPIN(xb_ld(&bar[XB_XGEN(b.x)]) == gen, bar);
            __builtin_amdgcn_fence(__ATOMIC_ACQUIRE, "agent");
            asm volatile("s_waitcnt vmcnt(0)" ::: "memory");
        }
    }
    __syncthreads();
}
namespace mk {
constexpr int NL = 32768, NC = 4096, NTOK = NL + NC, D = 1024, FF = 2816;
constexpr size_t MiB = 1u << 20;
constexpr size_t WS_CTL = 0, CTL_ZERO_BYTES = 1 * MiB;
constexpr size_t WS_MOD = 1 * MiB;
constexpr size_t WS_ROPE = 2 * MiB;
constexpr size_t WS_WIN0 = 4 * MiB, WS_WOUT0 = 10 * MiB, WS_WIN1 = 12 * MiB, WS_WOUT1 = 16 * MiB, WS_WUP0 = 18 * MiB, WS_WUP1 = 29 * MiB, WS_WDN0 = 40 * MiB, WS_WDN1 = 46 * MiB;
constexpr size_t WS_ACT = 56 * MiB + 2048;
constexpr size_t WS_XC = 132 * MiB;
constexpr size_t WS_BIG = 150 * MiB;
constexpr size_t WS_BG = WS_BIG, WS_U = WS_BIG + 36 * MiB, WS_Q = WS_BIG + 72 * MiB, WS_K = WS_BIG + 108 * MiB, WS_V = WS_BIG + 144 * MiB;
constexpr size_t WS_HACT = WS_BIG;
constexpr size_t WS_PV = WS_BIG, WS_QF = WS_BIG + 32 * MiB, WS_QB = WS_BIG + 48 * MiB, WS_KF = WS_BIG + 64 * MiB, WS_KB = WS_BIG + 82 * MiB, WS_V1 = WS_BIG + 100 * MiB, WS_G1 = WS_BIG + 136 * MiB;
constexpr size_t WS_T = WS_BIG + 168 * MiB;
constexpr size_t WS_ST = WS_BIG + 240 * MiB;
constexpr size_t WS_END = WS_BIG + 272 * MiB;
static_assert(WS_END <= 512 * MiB, "d_ws map");
constexpr int CW_BAR = 4096;
constexpr int RING_BYTES = 131072, SIDE_OFF = RING_BYTES, SIDE_BYTES = 16384, MISC_OFF = SIDE_OFF + SIDE_BYTES, LDS_BYTES = MISC_OFF + 512;

struct Args { const float* in[29]; float* out; unsigned char* ws; int ph_lo, ph_hi; };

struct Frame {
    LAS unsigned char* lds;
    int tid, lane, wave, vcu, G;
    const float* const* in; float* out; unsigned char* ws;
};

__device__ __forceinline__ int plain8(int tc) { const int bj = tc >> 7, wc = (tc >> 5) & 3, n = (tc >> 4) & 1, fq = (tc >> 2) & 3, j = tc & 3; return 128 * bj + 32 * wc + 8 * fq + 4 * n + j; }
__device__ __forceinline__ int head64(int tc) { const int bj = tc >> 7, n = (tc >> 4) & 1, fq = (tc >> 2) & 3, j = tc & 3; return 32 * bj + 16 * n + 4 * fq + j; }
enum { SG_ID = 0, SG_IN0 = 1, SG_UP = 2, SG_IN1 = 3 };
__device__ __forceinline__ int sigma(int kind, int np) {
    const int pn = np >> 8, tc = np & 255, bj = tc >> 7, wc = (tc >> 5) & 3;
    if (kind == SG_IN0) {
        if (pn < 2) return 256 * pn + plain8(tc);
        if (pn < 6) return (bj ? 1024 : 512) + 128 * (pn - 2) + (plain8(tc) & 127);
        if (pn < 10) return 1536 + 64 * ((pn - 6) * 4 + wc) + head64(tc);
        return 2560 + 256 * (pn - 10) + plain8(tc);
    }
    if (kind == SG_UP) return (bj ? FF : 0) + 128 * pn + (plain8(tc) & 127);
    if (kind == SG_IN1) {
        if (pn < 2) return 256 * pn + plain8(tc);
        if (pn == 2) return 512 + 64 * wc + head64(tc);
        if (pn == 3) return 768 + 64 * wc + head64(tc);
        if (pn < 6) return 1024 + 256 * (pn - 4) + plain8(tc);
        return 1536 + 256 * (pn - 6) + plain8(tc);
    }
    return np;
}
__device__ __forceinline__ void transpose_item(const float* W, int K, int N, bf16_t* WT, int kind, LAS float* scr, int item, int lane) {
    const int nblk = N / 32, kb = item / nblk, nb = item % nblk, k0 = 64 * kb, n0 = 32 * nb;
    const int scol = sigma(kind, n0 + (lane & 31));
#pragma unroll 8
    for (int i = 0; i < 32; ++i) { const int kk = 2 * i + (lane >> 5); scr[kk * 33 + (lane & 31)] = W[(size_t)(k0 + kk) * N + scol]; }
    asm volatile("s_waitcnt lgkmcnt(0)" ::: "memory");
    const int c = lane & 7;
#pragma unroll
    for (int j = 0; j < 4; ++j) { const int n = (lane >> 3) + 8 * j; const LAS float* s = scr + (8 * c) * 33 + n;
        u32x4 o; o.x = cvt_pk_bf16(s[0 * 33], s[1 * 33]); o.y = cvt_pk_bf16(s[2 * 33], s[3 * 33]); o.z = cvt_pk_bf16(s[4 * 33], s[5 * 33]); o.w = cvt_pk_bf16(s[6 * 33], s[7 * 33]);
        *(u32x4*)(WT + (size_t)(n0 + n) * K + k0 + 8 * c) = o; }
    asm volatile("s_waitcnt lgkmcnt(0)" ::: "memory");
}
__device__ __forceinline__ void poolfold_item(const float* pw, const float* ps, const float* wo, bf16_t* WT, int item, int lane) {
    const int db = item & 15, cb = (item >> 4) & 15, g = item >> 8, d = db * 64 + lane, c0 = cb * 8;
    float acc[8];
#pragma unroll
    for (int i = 0; i < 8; ++i) acc[i] = 0.f;
    for (int e = 0; e < 128; ++e) {
        const float w = wo[(size_t)(g * 128 + e) * 1024 + d] * ps[g * 128 + e];
#pragma unroll
        for (int i = 0; i < 8; ++i) acc[i] += pw[((size_t)g * 128 + c0 + i) * 128 + e] * w;
    }
    u32x4 o; o.x = cvt_pk_bf16(acc[0], acc[1]); o.y = cvt_pk_bf16(acc[2], acc[3]); o.z = cvt_pk_bf16(acc[4], acc[5]); o.w = cvt_pk_bf16(acc[6], acc[7]);
    *(u32x4*)(WT + (size_t)d * 1024 + g * 128 + c0) = o;
}
__device__ __forceinline__ void mod_item(Frame& F, int item) {
    const float* c = F.in[1]; const float* cc = F.in[3]; const float* mw = F.in[4]; const float* mb = F.in[5];
    float* MOD = (float*)(F.ws + WS_MOD);
    const int i = item / 96, cg = item % 96, col = cg * 64 + F.lane;
    LAS float* sc = (LAS float*)(F.lds);
    LAS float* part = (LAS float*)(F.lds + 81920);
    for (int e = F.tid; e < 17 * 1024; e += 512) { const int r = e >> 10, k = e & 1023; const float v = r < 16 ? c[r * 1024 + k] : cc[k]; sc[e] = v / (1.f + __expf(-v)); }
    __syncthreads();
    float acc[17];
#pragma unroll
    for (int r = 0; r < 17; ++r) acc[r] = 0.f;
    const int kbeg = F.wave * 128;
    for (int k = kbeg; k < kbeg + 128; ++k) {
        const float w = mw[((size_t)i * 1024 + k) * 6144 + col];
#pragma unroll
        for (int r = 0; r < 17; ++r) acc[r] += sc[r * 1024 + k] * w;
    }
#pragma unroll
    for (int r = 0; r < 17; ++r) part[(F.wave * 17 + r) * 64 + F.lane] = acc[r];
    __syncthreads();
    for (int e = F.tid; e < 17 * 64; e += 512) { const int r = e >> 6, l = e & 63; float s = mb[i * 6144 + cg * 64 + l];
#pragma unroll
        for (int w = 0; w < 8; ++w) s += part[(w * 17 + r) * 64 + l];
        MOD[((size_t)i * 17 + r) * 6144 + cg * 64 + l] = s; }
    __syncthreads();
}
__device__ __forceinline__ void p0_prologue(Frame& F) {
    for (int it = F.vcu; it < 192; it += F.G) mod_item(F, it);
    LAS float* scr = (LAS float*)(F.lds + F.wave * 16384);
    const int gw = F.vcu * 8 + F.wave, NGW = F.G * 8;
    constexpr int I_IN0 = 16 * 96, I_OUT0 = 16 * 32, I_IN1 = 16 * 64, I_OUT1H = 8 * 32  , I_UP = 16 * 176, I_DN = 44 * 32, I_FOLD = 4 * 16 * 16;
    constexpr int NITEMS = I_IN0 + I_OUT0 + I_IN1 + I_OUT1H + 2 * I_UP + 2 * I_DN + I_FOLD;
    for (int it = gw; it < NITEMS; it += NGW) {
        int r = it;
        if (r < I_FOLD) { poolfold_item(F.in[20], F.in[21], F.in[19], (bf16_t*)(F.ws + WS_WOUT1), r, F.lane); continue; } r -= I_FOLD;
        if (r < I_IN0) { transpose_item(F.in[8], 1024, 3072, (bf16_t*)(F.ws + WS_WIN0), SG_IN0, scr, r, F.lane); continue; } r -= I_IN0;
        if (r < I_OUT0) { transpose_item(F.in[9], 1024, 1024, (bf16_t*)(F.ws + WS_WOUT0), SG_ID, scr, r, F.lane); continue; } r -= I_OUT0;
        if (r < I_IN1) { transpose_item(F.in[18], 1024, 2048, (bf16_t*)(F.ws + WS_WIN1), SG_IN1, scr, r, F.lane); continue; } r -= I_IN1;
        if (r < I_OUT1H) {
            transpose_item(F.in[19], 1024, 1024, (bf16_t*)(F.ws + WS_WOUT1), SG_ID, scr, r + 8 * 32, F.lane); continue; } r -= I_OUT1H;
        if (r < 2 * I_UP) { const int l = r / I_UP; transpose_item(F.in[25] + (size_t)l * 1024 * 5632, 1024, 5632, (bf16_t*)(F.ws + (l ? WS_WUP1 : WS_WUP0)), SG_UP, scr, r % I_UP, F.lane); continue; } r -= 2 * I_UP;
        { const int l = r / I_DN; transpose_item(F.in[28] + (size_t)l * FF * 1024, FF, 1024, (bf16_t*)(F.ws + (l ? WS_WDN1 : WS_WDN0)), SG_ID, scr, r % I_DN, F.lane); }
    }
    if (F.vcu == 0) for (int e = F.tid; e < 1024; e += 512) { const int idx = e >> 4, f = e & 15; const float inv = powf(10000.f, -(float)f / 16.f), ang = (float)idx * inv;
        ((float*)(F.ws + WS_ROPE))[e] = cosf(ang); ((float*)(F.ws + WS_ROPE))[1024 + e] = sinf(ang); }
}
__device__ __forceinline__ void norm_pass(Frame& F, const float* xl, const float* xc, int nrows, const float* gain, const float* mod  , int shoff) {
    bf16_t* H = (bf16_t*)(F.ws + WS_ACT);
    const int gw = F.vcu * 8 + F.wave, NGW = F.G * 8;
    for (int row = gw; row < nrows; row += NGW) {
        const float* xr = row < NL ? xl + (size_t)row * D : xc + (size_t)(row - NL) * D;
        const float* mrow = mod + (size_t)(row < NL ? (row >> 11) : 16) * 6144 + shoff;
        f32x4 v[4]; float s = 0.f;
#pragma unroll
        for (int j = 0; j < 4; ++j) { v[j] = ((const f32x4*)xr)[F.lane + 64 * j]; s += (v[j].x * v[j].x + v[j].y * v[j].y) + (v[j].z * v[j].z + v[j].w * v[j].w); }
        const float r = rsqrtf(wave_sum(s) * (1.f / D) + 1e-6f);
#pragma unroll
        for (int j = 0; j < 4; ++j) {
            const f32x4 g = ((const f32x4*)gain)[F.lane + 64 * j], sh = ((const f32x4*)mrow)[F.lane + 64 * j], sc = ((const f32x4*)(mrow + 1024))[F.lane + 64 * j];
            const f32x4 o = v[j] * r * g * (sc + 1.f) + sh;
            u32x2 w; w.x = cvt_pk_bf16(o.x, o.y); w.y = cvt_pk_bf16(o.z, o.w);
            ((u32x2*)(H + (size_t)row * D))[F.lane + 64 * j] = w;
        }
    }
}
typedef f32x4 Acc[2][2][4][2];
__device__ __forceinline__ u32x4 pack8(const f32x4 a, const f32x4 b) { u32x4 w; w.x = cvt_pk_bf16(a[0], a[1]); w.y = cvt_pk_bf16(a[2], a[3]); w.z = cvt_pk_bf16(b[0], b[1]); w.w = cvt_pk_bf16(b[2], b[3]); return w; }
__device__ __forceinline__ u32x2 pack4(const f32x4 a) { u32x2 w; w.x = cvt_pk_bf16(a[0], a[1]); w.y = cvt_pk_bf16(a[2], a[3]); return w; }

struct EpiIn0 {
    unsigned char* ws; const float* qg; const float* kg;
    __device__ __forceinline__ void operator()(Acc& acc, const pg8::Unit& u, int wr, int wc, int fr, int fq) const {
        const int row0 = u.pm * 256 + wr * 64 + fr, pn = u.pn;
        if (pn < 2 || pn >= 10) {
            bf16_t* O = (bf16_t*)(ws + (pn < 2 ? WS_BG : WS_V)); const int colt = (pn < 2 ? pn : pn - 10) * 256 + wc * 32 + 8 * fq;
#pragma unroll
            for (int ai = 0; ai < 2; ++ai)
#pragma unroll
                for (int m = 0; m < 4; ++m)
#pragma unroll
                    for (int bj = 0; bj < 2; ++bj) *(u32x4*)(O + (size_t)(row0 + ai * 128 + m * 16) * 512 + colt + bj * 128) = pack8(acc[ai][bj][m][0], acc[ai][bj][m][1]);
        } else if (pn < 6) {
            bf16_t* O = (bf16_t*)(ws + WS_U); const int colt = (pn - 2) * 128 + wc * 32 + 8 * fq;
#pragma unroll
            for (int ai = 0; ai < 2; ++ai)
#pragma unroll
                for (int m = 0; m < 4; ++m) *(u32x4*)(O + (size_t)(row0 + ai * 128 + m * 16) * 512 + colt) = pack8(acc[ai][0][m][0] * acc[ai][1][m][0], acc[ai][0][m][1] * acc[ai][1][m][1]);
        } else {
            const int ch = (pn - 6) * 4 + wc; const bool isk = ch >= 8;
            bf16_t* O = (bf16_t*)(ws + (isk ? WS_K : WS_Q)) + 64 * (ch & 7);
            const float* gp = isk ? kg : qg; const float gs = isk ? 1.f : 0.125f * 1.4426950408889634f;
            f32x4 gv[2][2];
#pragma unroll
            for (int bj = 0; bj < 2; ++bj)
#pragma unroll
                for (int n = 0; n < 2; ++n) gv[bj][n] = *(const f32x4*)(gp + 32 * bj + 16 * n + 4 * fq) * gs;
            const float* ct = (const float*)(ws + WS_ROPE);
#pragma unroll
            for (int ai = 0; ai < 2; ++ai)
#pragma unroll
                for (int m = 0; m < 4; ++m) {
                    const int row = row0 + ai * 128 + m * 16;
                    float ss = 0.f;
#pragma unroll
                    for (int bj = 0; bj < 2; ++bj)
#pragma unroll
                        for (int n = 0; n < 2; ++n) { const f32x4 x = acc[ai][bj][m][n]; ss += (x[0] * x[0] + x[1] * x[1]) + (x[2] * x[2] + x[3] * x[3]); }
                    ss += __shfl_xor(ss, 16); ss += __shfl_xor(ss, 32);
                    const float ri = rsqrtf(ss * (1.f / 64.f) + 1e-6f);
                    const bool rot = row < NL; const int pos = row & 2047;
#pragma unroll
                    for (int bj = 0; bj < 2; ++bj) {
                        f32x4 x1 = acc[ai][bj][m][0] * ri * gv[bj][0], x2 = acc[ai][bj][m][1] * ri * gv[bj][1];
                        if (rot) { const int idx = bj ? (pos & 63) : (pos >> 6);
                            const f32x4 cs = *(const f32x4*)(ct + idx * 16 + 4 * fq), sn = *(const f32x4*)(ct + 1024 + idx * 16 + 4 * fq);
                            const f32x4 o1 = x1 * cs - x2 * sn, o2 = x1 * sn + x2 * cs; x1 = o1; x2 = o2; }
                        *(u32x2*)(O + (size_t)row * 512 + 32 * bj + 4 * fq) = pack4(x1);
                        *(u32x2*)(O + (size_t)row * 512 + 32 * bj + 16 + 4 * fq) = pack4(x2);
                    }
                }
        }
    }
};
struct EpiRes {
    const float* xin_l; const float* xin_c; float* xout_l; float* xout_c; const float* mod; int goff;
    __device__ __forceinline__ void operator()(Acc& acc, const pg8::Unit& u, int wr, int wc, int fr, int fq) const {
        const int trow = u.pm * 256; const bool lat = trow < NL;
        const float* xin = lat ? xin_l + (size_t)trow * D : xin_c + (size_t)(trow - NL) * D;
        float* xout = lat ? xout_l + (size_t)trow * D : xout_c + (size_t)(trow - NL) * D;
        const float* gp = mod + (size_t)(lat ? (trow >> 11) : 16) * 6144 + goff;
        const int col0 = u.pn * 256 + wc * 32 + 4 * fq;
        f32x4 gv[2][2];
#pragma unroll
        for (int bj = 0; bj < 2; ++bj)
#pragma unroll
            for (int n = 0; n < 2; ++n) gv[bj][n] = *(const f32x4*)(gp + col0 + bj * 128 + n * 16);
#pragma unroll
        for (int ai = 0; ai < 2; ++ai)
#pragma unroll
            for (int m = 0; m < 4; ++m) { const size_t off = (size_t)(ai * 128 + wr * 64 + m * 16 + fr) * D + col0;
#pragma unroll
                for (int bj = 0; bj < 2; ++bj)
#pragma unroll
                    for (int n = 0; n < 2; ++n) { const f32x4 xi = *(const f32x4*)(xin + off + bj * 128 + n * 16); *(f32x4*)(xout + off + bj * 128 + n * 16) = xi + gv[bj][n] * acc[ai][bj][m][n]; }
                if (m & 1) asm volatile("" ::: "memory"); }
    }
};
template <int CTRL> __device__ __forceinline__ float dpp_mov(float old, float src) { return __int_as_float(__builtin_amdgcn_update_dpp(__float_as_int(old), __float_as_int(src), CTRL, 0xf, 0xf, false)); }
struct EpiUp {
    bf16_t* HACT; const float* cw; const float* cb; int ntok; LAS float* edge;
    __device__ __forceinline__ void operator()(Acc& acc, const pg8::Unit& u, int wr, int wc, int fr, int fq) const {
#pragma unroll
        for (int ai = 0; ai < 2; ++ai) {
            if (fr == 0) { *(f32x4*)(edge + (((wr * 4 + wc) * 2 + ai) * 2 + 0) * 32 + 8 * fq) = acc[ai][0][0][0]; *(f32x4*)(edge + (((wr * 4 + wc) * 2 + ai) * 2 + 0) * 32 + 8 * fq + 4) = acc[ai][0][0][1]; }
            if (fr == 15) { *(f32x4*)(edge + (((wr * 4 + wc) * 2 + ai) * 2 + 1) * 32 + 8 * fq) = acc[ai][0][3][0]; *(f32x4*)(edge + (((wr * 4 + wc) * 2 + ai) * 2 + 1) * 32 + 8 * fq + 4) = acc[ai][0][3][1]; }
        }
        asm volatile("s_waitcnt lgkmcnt(0)" ::: "memory"); __builtin_amdgcn_s_barrier(); asm volatile("" ::: "memory");
        const int colh = u.pn * 128 + wc * 32 + 8 * fq;
        f32x4 w0[2], w1[2], w2[2], bb[2];
#pragma unroll
        for (int n = 0; n < 2; ++n) { w0[n] = *(const f32x4*)(cw + colh + 4 * n); w1[n] = *(const f32x4*)(cw + FF + colh + 4 * n); w2[n] = *(const f32x4*)(cw + 2 * FF + colh + 4 * n); bb[n] = *(const f32x4*)(cb + colh + 4 * n); }
        const int tok0 = u.pm * 254 - 1;
#pragma unroll
        for (int ai = 0; ai < 2; ++ai) {
            const int seg = 2 * ai + wr;
            f32x4 pe[2], ne[2];
            { const int ps = seg - 1, ns = seg + 1;
              const LAS float* pp = edge + ((((ps & 1) * 4 + wc) * 2 + (ps >> 1)) * 2 + 1) * 32 + 8 * fq;
              const LAS float* np_ = edge + ((((ns & 1) * 4 + wc) * 2 + (ns >> 1)) * 2 + 0) * 32 + 8 * fq;
#pragma unroll
              for (int n = 0; n < 2; ++n) { pe[n] = seg > 0 ? *(const LAS f32x4*)(pp + 4 * n) : (f32x4){0.f, 0.f, 0.f, 0.f}; ne[n] = seg < 3 ? *(const LAS f32x4*)(np_ + 4 * n) : (f32x4){0.f, 0.f, 0.f, 0.f}; } }
#pragma unroll
            for (int m = 0; m < 4; ++m) {
                const int r = 128 * ai + 64 * wr + 16 * m + fr, tok = tok0 + r;
                const bool first = tok < NL ? (tok & 2047) == 0 : (tok & 255) == 0;
                const int tn = tok + 1; const bool last = (tn >= ntok) || (tn < NL ? (tn & 2047) == 0 : (tn & 255) == 0);
                f32x4 hv[2];
#pragma unroll
                for (int n = 0; n < 2; ++n) {
                    f32x4 pv, nv;
#pragma unroll
                    for (int j = 0; j < 4; ++j) {
                        const float cur = acc[ai][0][m][n][j];
                        const float pold = m > 0 ? dpp_mov<0x121>(0.f, acc[ai][0][m > 0 ? m - 1 : 0][n][j]) : pe[n][j];
                        const float nold = m < 3 ? dpp_mov<0x12F>(0.f, acc[ai][0][m < 3 ? m + 1 : 3][n][j]) : ne[n][j];
                        pv[j] = dpp_mov<0x111>(pold, cur);
                        nv[j] = dpp_mov<0x101>(nold, cur);
                    }
                    if (first) pv = (f32x4){0.f, 0.f, 0.f, 0.f};
                    if (last) nv = (f32x4){0.f, 0.f, 0.f, 0.f};
                    const f32x4 a = pv * w0[n] + acc[ai][0][m][n] * w1[n] + nv * w2[n] + bb[n];
#pragma unroll
                    for (int j = 0; j < 4; ++j) hv[n][j] = fast_silu(a[j]) * acc[ai][1][m][n][j];
                }
                if (r >= 1 && r <= 254 && tok < ntok) *(u32x4*)(HACT + (size_t)tok * FF + colh) = pack8(hv[0], hv[1]);
            }
        }
    }
};
struct EpiIn1 {
    unsigned char* ws; const float* decf; const float* decb;
    __device__ __forceinline__ void operator()(Acc& acc, const pg8::Unit& u, int wr, int wc, int fr, int fq) const {
        const int row0 = u.pm * 256 + wr * 64 + fr, pn = u.pn;
        if (pn == 2 || pn == 3) {
            const bool isk = pn == 3; const int h = wc;
            const float lf2 = -__expf(decf[h]) * 1.4426950408889634f, lb2 = -__expf(decb[h]) * 1.4426950408889634f;
            bf16_t* OF = (bf16_t*)(ws + (isk ? WS_KF : WS_QF)) + 64 * h; bf16_t* OB = (bf16_t*)(ws + (isk ? WS_KB : WS_QB)) + 64 * h;
            const float* ct = (const float*)(ws + WS_ROPE);
#pragma unroll
            for (int ai = 0; ai < 2; ++ai)
#pragma unroll
                for (int m = 0; m < 4; ++m) {
                    const int row = row0 + ai * 128 + m * 16; const bool rot = row < NL; const int pos = row & 2047; const float p = (float)(row & 127);
                    const float sf = isk ? __builtin_amdgcn_exp2f(-lf2 * p) : 0.125f * __builtin_amdgcn_exp2f(lf2 * p);
                    const float sb = isk ? __builtin_amdgcn_exp2f(lb2 * (p - 127.f)) : 0.125f * __builtin_amdgcn_exp2f(lb2 * (127.f - p));
#pragma unroll
                    for (int bj = 0; bj < 2; ++bj) {
                        f32x4 x1 = acc[ai][bj][m][0], x2 = acc[ai][bj][m][1];
                        if (rot) { const int idx = bj ? (pos & 63) : (pos >> 6);
                            const f32x4 cs = *(const f32x4*)(ct + idx * 16 + 4 * fq), sn = *(const f32x4*)(ct + 1024 + idx * 16 + 4 * fq);
                            const f32x4 o1 = x1 * cs - x2 * sn, o2 = x1 * sn + x2 * cs; x1 = o1; x2 = o2; }
                        *(u32x2*)(OF + (size_t)row * 256 + 32 * bj + 4 * fq) = pack4(x1 * sf); *(u32x2*)(OF + (size_t)row * 256 + 32 * bj + 16 + 4 * fq) = pack4(x2 * sf);
                        *(u32x2*)(OB + (size_t)row * 256 + 32 * bj + 4 * fq) = pack4(x1 * sb); *(u32x2*)(OB + (size_t)row * 256 + 32 * bj + 16 + 4 * fq) = pack4(x2 * sb);
                    }
                }
        } else {
            const bool isg = pn >= 6;
            bf16_t* O = (bf16_t*)(ws + (pn < 2 ? WS_PV : (pn < 6 ? WS_V1 : WS_G1))); const int colt = (pn < 2 ? pn : (pn < 6 ? pn - 4 : pn - 6)) * 256 + wc * 32 + 8 * fq;
#pragma unroll
            for (int ai = 0; ai < 2; ++ai)
#pragma unroll
                for (int m = 0; m < 4; ++m)
#pragma unroll
                    for (int bj = 0; bj < 2; ++bj) { f32x4 a = acc[ai][bj][m][0], b = acc[ai][bj][m][1];
                        if (isg) {
#pragma unroll
                            for (int j = 0; j < 4; ++j) { a[j] = fast_silu(a[j]); b[j] = fast_silu(b[j]); } }
                        *(u32x4*)(O + (size_t)(row0 + ai * 128 + m * 16) * 512 + colt + bj * 128) = pack8(a, b); }
        }
    }
};
struct OrderIn1 {
    pg8::StaticOrder so; int G, c;
    __device__ void init(int G_, int c_) { so.init(128, 8, G_, c_); G = G_; c = c_; }
    __device__ bool next(int i, pg8::Unit& u) const {
        const int L = i * G + c;
        if (L < 1024) return so.next(i, u);
        const int e = L - 1024; if (e >= 48) return false;
        u.pm = 128 + e / 3; u.pn = 3 + e % 3; return true;
    }
};
}
namespace mk {
#define MFMA32(a, b, c) __builtin_amdgcn_mfma_f32_32x32x16_bf16((a), (b), (c), 0, 0, 0)
__device__ __forceinline__ bf16x8 as_bf16x8(u32x4 v) { return __builtin_bit_cast(bf16x8, v); }

struct AttnCtx { const bf16_t* Q; const bf16_t* K; const bf16_t* V; bf16_t* A2; const float* subln; float lam, negMb; };
__device__ __forceinline__ void attn_unit(Frame& F, const AttnCtx& C, int h, int qrow0, int ka, int nta, int kb, int ntb) {
    const int lane = F.lane, w = F.wave, r32 = lane & 31, hi = lane >> 5, mp = w >> 2, qb = w & 3;
    const unsigned lds0 = (unsigned)(uintptr_t)F.lds;
    const LAS char* L = (const LAS char*)F.lds;
    LAS float* wsf = (LAS float*)(F.lds + 98304 + 256 * w);
    const bf16_t* qp = C.Q + (size_t)(qrow0 + 32 * qb + r32) * 512 + h * 128 + mp * 64 + hi * 8;
    bf16x8 qr[4];
#pragma unroll
    for (int d0 = 0; d0 < 4; ++d0) qr[d0] = *(const bf16x8*)(qp + d0 * 16);
    const bf16_t* ksrc = C.K + (size_t)lane * 512 + h * 128 + w * 8;
    const int pv0 = 2 * w, pv1 = 2 * w + 1;
    const bf16_t* vsrc0 = C.V + (size_t)(16 * (pv0 & 3) + (lane >> 2)) * 512 + h * 128 + (pv0 >> 2) * 32 + (lane & 3) * 8;
    const bf16_t* vsrc1 = C.V + (size_t)(16 * (pv1 & 3) + (lane >> 2)) * 512 + h * 128 + (pv1 >> 2) * 32 + (lane & 3) * 8;
    const int NT = nta + ntb;
#define AT_ISSUE(t, slot) do { const int t_ = (t); const size_t ko_ = (size_t)(t_ < nta ? ka + 64 * t_ : kb + 64 * (t_ - nta)) * 512; const unsigned sb_ = lds0 + (unsigned)(slot) * 32768u; \
        glds16(ksrc + ko_, (unsigned)__builtin_amdgcn_readfirstlane(sb_ + w * 1024)); glds16(ksrc + ko_ + 64, (unsigned)__builtin_amdgcn_readfirstlane(sb_ + 8192 + w * 1024)); \
        glds16(vsrc0 + ko_, (unsigned)__builtin_amdgcn_readfirstlane(sb_ + 16384 + pv0 * 1024)); glds16(vsrc1 + ko_, (unsigned)__builtin_amdgcn_readfirstlane(sb_ + 16384 + pv1 * 1024)); } while (0)
    AT_ISSUE(0, 0); AT_ISSUE(1, 1);
    f32x16 o[4];
#pragma unroll
    for (int d0 = 0; d0 < 4; ++d0)
#pragma unroll
        for (int r = 0; r < 16; ++r) o[d0][r] = 0.f;
    float lsum = 0.f;
    int slot = 0;
    for (int t = 0; t < NT; ++t) {
        if (t + 1 < NT) { WAIT_BAR(4); } else { WAIT_BAR(0); }
        int s2 = slot + 2; if (s2 >= 3) s2 -= 3;
        if (t + 2 < NT) AT_ISSUE(t + 2, s2);
        const LAS char* kbp = L + slot * 32768 + mp * 8192 + hi * 1024 + r32 * 16;
        f32x16 p0, p1;
#pragma unroll
        for (int r = 0; r < 16; ++r) { p0[r] = C.negMb; p1[r] = C.negMb; }
#pragma unroll
        for (int d0 = 0; d0 < 4; ++d0) {
            const bf16x8 b0 = *(const LAS bf16x8*)(kbp + d0 * 2048), b1 = *(const LAS bf16x8*)(kbp + d0 * 2048 + 512);
            p0 = MFMA32(b0, qr[d0], p0); p1 = MFMA32(b1, qr[d0], p1);
        }
#pragma unroll
        for (int r = 0; r < 16; ++r) { p0[r] = __builtin_amdgcn_exp2f(p0[r]); p1[r] = __builtin_amdgcn_exp2f(p1[r]); lsum += p0[r] + p1[r]; }
        u32x4 pw[4];
#pragma unroll
        for (int i = 0; i < 4; ++i) { pw[0][i] = cvt_pk_bf16(p0[2 * i], p0[2 * i + 1]); pw[1][i] = cvt_pk_bf16(p0[8 + 2 * i], p0[9 + 2 * i]); pw[2][i] = cvt_pk_bf16(p1[2 * i], p1[2 * i + 1]); pw[3][i] = cvt_pk_bf16(p1[8 + 2 * i], p1[9 + 2 * i]); }
        const LAS char* vbp = L + slot * 32768 + 16384 + ((lane >> 4) & 1) * 32 + (lane & 3) * 8 + (4 * hi + ((lane & 15) >> 2)) * 64;
#pragma unroll
        for (int d0 = 0; d0 < 4; ++d0)
#pragma unroll
            for (int ks = 0; ks < 4; ++ks) {
                const s16x4 lo = tr_read(vbp + d0 * 4096 + ks * 1024), hh = tr_read(vbp + d0 * 4096 + ks * 1024 + 512);
                o[d0] = MFMA32(as_bf16x8(pw[ks]), cat8(lo, hh), o[d0]);
            }
        slot = slot + 1; if (slot >= 3) slot = 0;
    }
#undef AT_ISSUE
    lsum += __shfl_xor(lsum, 32);
    if (hi == 0) wsf[r32] = (mp ? C.lam : 1.f) / lsum;
    asm volatile("s_waitcnt lgkmcnt(0)" ::: "memory");
    float rli[16];
#pragma unroll
    for (int r = 0; r < 16; ++r) rli[r] = wsf[crow(r, hi)];
    asm volatile("s_waitcnt lgkmcnt(0)" ::: "memory"); __builtin_amdgcn_s_barrier(); asm volatile("" ::: "memory");
    LAS float* CB = (LAS float*)F.lds;
    if (mp == 1) {
#pragma unroll
        for (int d0 = 0; d0 < 4; ++d0)
#pragma unroll
            for (int r = 0; r < 16; ++r) CB[(32 * qb + crow(r, hi)) * 132 + 32 * d0 + r32] = o[d0][r] * rli[r];
    }
    asm volatile("s_waitcnt lgkmcnt(0)" ::: "memory"); __builtin_amdgcn_s_barrier(); asm volatile("" ::: "memory");
    if (mp == 0) {
#pragma unroll
        for (int d0 = 0; d0 < 4; ++d0)
#pragma unroll
            for (int r = 0; r < 16; ++r) { LAS float* p = CB + (32 * qb + crow(r, hi)) * 132 + 32 * d0 + r32; *p = o[d0][r] * rli[r] - *p; }
        asm volatile("s_waitcnt lgkmcnt(0)" ::: "memory");
        const int row = lane >> 1, half = lane & 1;
        const LAS float* rp = CB + (32 * qb + row) * 132 + 64 * half;
        f32x4 v[16]; float ss = 0.f;
#pragma unroll
        for (int i = 0; i < 16; ++i) { v[i] = *(const LAS f32x4*)(rp + 4 * i); ss += (v[i][0] * v[i][0] + v[i][1] * v[i][1]) + (v[i][2] * v[i][2] + v[i][3] * v[i][3]); }
        ss += __shfl_xor(ss, 1);
        const float ri = rsqrtf(ss * (1.f / 128.f) + 1e-6f) * 0.8f;
        bf16_t* op = C.A2 + (size_t)(qrow0 + 32 * qb + row) * 1024 + 512 + h * 128 + 64 * half;
#pragma unroll
        for (int i = 0; i < 8; ++i) {
            const f32x4 g0 = *(const f32x4*)(C.subln + 64 * half + 8 * i), g1 = *(const f32x4*)(C.subln + 64 * half + 8 * i + 4);
            *(u32x4*)(op + 8 * i) = pack8(v[2 * i] * ri * g0, v[2 * i + 1] * ri * g1);
        }
    }
    asm volatile("s_waitcnt lgkmcnt(0)" ::: "memory"); __builtin_amdgcn_s_barrier(); asm volatile("" ::: "memory");
}
__device__ __forceinline__ void attn_phase(Frame& F) {
    AttnCtx C;
    C.Q = (const bf16_t*)(F.ws + WS_Q); C.K = (const bf16_t*)(F.ws + WS_K); C.V = (const bf16_t*)(F.ws + WS_V); C.A2 = (bf16_t*)(F.ws + WS_ACT); C.subln = F.in[17];
    {
        const float a1 = wave_sum(F.in[13][F.lane] * F.in[14][F.lane]), a2 = wave_sum(F.in[15][F.lane] * F.in[16][F.lane]);
        C.lam = __expf(a1) - __expf(a2) + 0.2f;
        const float mq = wave_max(fabsf(F.in[11][F.lane])), mkk = wave_max(fabsf(F.in[12][F.lane]));
        C.negMb = -(8.f * mq * mkk * 1.4426950408889634f * 1.01f + 0.1f);
    }
    for (int u = F.vcu; u < 1152; u += F.G) {
        if (u < 1024) { const int b = u >> 6, h = (u >> 4) & 3, qb = u & 15; attn_unit(F, C, h, b * 2048 + 128 * qb, b * 2048, 32, NL + b * 256, 4); }
        else { const int e = u - 1024, b = e >> 3, h = (e >> 1) & 3, qb = e & 1; attn_unit(F, C, h, NL + b * 256 + 128 * qb, NL + b * 256, 4, 0, 0); }
    }
}
__device__ __forceinline__ void convgate_pass(Frame& F) {
    const bf16_t* BG = (const bf16_t*)(F.ws + WS_BG); const bf16_t* U = (const bf16_t*)(F.ws + WS_U); bf16_t* A2 = (bf16_t*)(F.ws + WS_ACT); const float* cw = F.in[10];
    for (int it = F.vcu * 512 + F.tid; it < NTOK * 64; it += F.G * 512) {
        const int row = it >> 6, c = (it & 63) * 8;
        const bool first = row < NL ? (row & 2047) == 0 : (row & 255) == 0, last = row < NL ? (row & 2047) == 2047 : (row & 255) == 255;
        const u32x4 z = {0u, 0u, 0u, 0u};
        const u32x4 bg = *(const u32x4*)(BG + (size_t)row * 512 + c), u1 = *(const u32x4*)(U + (size_t)row * 512 + c);
        const u32x4 u0 = first ? z : *(const u32x4*)(U + (size_t)(row - 1) * 512 + c), u2 = last ? z : *(const u32x4*)(U + (size_t)(row + 1) * 512 + c);
        float o[8];
#pragma unroll
        for (int i = 0; i < 4; ++i) {
            const float w0a = cw[c + 2 * i], w0b = cw[c + 2 * i + 1], w1a = cw[512 + c + 2 * i], w1b = cw[512 + c + 2 * i + 1], w2a = cw[1024 + c + 2 * i], w2b = cw[1024 + c + 2 * i + 1];
            o[2 * i] = bf_lo(bg[i]) * (bf_lo(u0[i]) * w0a + bf_lo(u1[i]) * w1a + bf_lo(u2[i]) * w2a);
            o[2 * i + 1] = bf_hi(bg[i]) * (bf_hi(u0[i]) * w0b + bf_hi(u1[i]) * w1b + bf_hi(u2[i]) * w2b);
        }
        u32x4 w; w.x = cvt_pk_bf16(o[0], o[1]); w.y = cvt_pk_bf16(o[2], o[3]); w.z = cvt_pk_bf16(o[4], o[5]); w.w = cvt_pk_bf16(o[6], o[7]);
        *(u32x4*)(A2 + (size_t)row * 1024 + c) = w;
    }
}
__device__ __forceinline__ void pool_pass(Frame& F) {
    const bf16_t* PV = (const bf16_t*)(F.ws + WS_PV); bf16_t* A6 = (bf16_t*)(F.ws + WS_ACT);
    for (int it = F.vcu * 512 + F.tid; it < NL * 64; it += F.G * 512) {
        const int row = it >> 6, c = (it & 63) * 8, t = row & 2047, rad = 1 << (c >> 7);
        const int lo = max(t - rad, 0), hi = min(t + rad + 1, 2048);
        float s[8];
#pragma unroll
        for (int i = 0; i < 8; ++i) s[i] = 0.f;
        const bf16_t* base = PV + (size_t)(row - t) * 512 + c;
        for (int j = lo; j < hi; ++j) { const u32x4 v = *(const u32x4*)(base + (size_t)j * 512);
#pragma unroll
            for (int i = 0; i < 4; ++i) { s[2 * i] += bf_lo(v[i]); s[2 * i + 1] += bf_hi(v[i]); } }
        const float inv = 1.f / (float)(hi - lo);
        const u32x4 v = *(const u32x4*)(base + (size_t)t * 512);
        u32x4 w;
#pragma unroll
        for (int i = 0; i < 4; ++i) w[i] = cvt_pk_bf16(s[2 * i] * inv - bf_lo(v[i]), s[2 * i + 1] * inv - bf_hi(v[i]));
        *(u32x4*)(A6 + (size_t)row * 1024 + c) = w;
    }
}
__device__ __forceinline__ void dma_tile(const bf16_t* src, int ld, int nrows, int rowbytes, unsigned dst, int wi, int nw, int lane) {
    const int lpr = rowbytes >> 4, rpp = 64 / lpr, npieces = nrows / rpp;
    for (int p = wi; p < npieces; p += nw) {
        const int row = p * rpp + lane / lpr, ch = lane % lpr;
        glds16(src + (size_t)row * ld + ch * 8, (unsigned)__builtin_amdgcn_readfirstlane(dst + p * 1024));
    }
}
template <int ORD> __device__ __forceinline__ bf16x8 tr_frag(const LAS char* tile, int rs, int k0, int c0, int lane) {
    const int hi = lane >> 5, q = (lane & 15) >> 2;
    const int colb = (c0 + 16 * ((lane >> 4) & 1) + 4 * (lane & 3)) * 2;
    const int r0 = ORD ? k0 + 4 * hi + q : k0 + 8 * hi + q, r1 = ORD ? r0 + 8 : r0 + 4;
    return cat8(tr_read(tile + r0 * rs + colb), tr_read(tile + r1 * rs + colb));
}
__device__ __forceinline__ void ret_stageA(Frame& F) {
    const int lane = F.lane, w = F.wave;
    const unsigned lds0 = (unsigned)(uintptr_t)F.lds; const LAS char* L = (const LAS char*)F.lds;
    const bf16_t* KF = (const bf16_t*)(F.ws + WS_KF); const bf16_t* KB = (const bf16_t*)(F.ws + WS_KB); const bf16_t* V1 = (const bf16_t*)(F.ws + WS_V1);
    float* T = (float*)(F.ws + WS_T);
    for (int u = F.vcu; u < 1152; u += F.G) {
        const int b = u / 72, h = (u / 18) & 3, cc = u % 18;
        const int row0 = cc < 16 ? b * 2048 + cc * 128 : NL + b * 256 + (cc - 16) * 128;
        dma_tile(KF + (size_t)row0 * 256 + h * 64, 256, 128, 128, lds0, w, 8, lane);
        dma_tile(KB + (size_t)row0 * 256 + h * 64, 256, 128, 128, lds0 + 16384, w, 8, lane);
        dma_tile(V1 + (size_t)row0 * 512 + h * 128, 512, 128, 256, lds0 + 32768, w, 8, lane);
        WAIT_BAR(0);
        const int dir = w >> 2, mb = (w >> 1) & 1, nb0 = 2 * (w & 1);
        f32x16 acc[2];
#pragma unroll
        for (int i = 0; i < 2; ++i)
#pragma unroll
            for (int r = 0; r < 16; ++r) acc[i][r] = 0.f;
#pragma unroll
        for (int s = 0; s < 8; ++s) {
            const bf16x8 a = tr_frag<0>(L + dir * 16384, 128, 16 * s, 32 * mb, lane);
#pragma unroll
            for (int i = 0; i < 2; ++i) acc[i] = MFMA32(a, tr_frag<0>(L + 32768, 256, 16 * s, 32 * (nb0 + i), lane), acc[i]);
        }
        const float lg = -__expf((dir ? F.in[23] : F.in[22])[h]) * 1.4426950408889634f, sc = __builtin_amdgcn_exp2f(lg * 127.f);
        float* Tp = T + ((size_t)u * 2 + dir) * 8192;
#pragma unroll
        for (int i = 0; i < 2; ++i)
#pragma unroll
            for (int r = 0; r < 16; ++r) Tp[(32 * mb + crow(r, lane >> 5)) * 128 + 32 * (nb0 + i) + (lane & 31)] = acc[i][r] * sc;
        asm volatile("s_waitcnt lgkmcnt(0)" ::: "memory"); __builtin_amdgcn_s_barrier(); asm volatile("" ::: "memory");
    }
}
__device__ __forceinline__ void ret_scan(Frame& F) {
    const float* T = (const float*)(F.ws + WS_T); bf16_t* ST = (bf16_t*)(F.ws + WS_ST);
    for (int it = F.vcu * 512 + F.tid; it < 16 * 4 * 2 * 4096; it += F.G * 512) {
        const int e = (it & 4095) * 2, dir = (it >> 12) & 1, bh = it >> 13, h = bh & 3;
        const float lg = -__expf((dir ? F.in[23] : F.in[22])[h]) * 1.4426950408889634f, l128 = __builtin_amdgcn_exp2f(lg * 128.f), l1 = __builtin_amdgcn_exp2f(lg);
        const float* Tb = T + ((size_t)bh * 18 * 2 + dir) * 8192 + e;
        const float2 c0 = *(const float2*)(Tb + 16 * 16384), c1 = *(const float2*)(Tb + 17 * 16384);
        float sx, sy;
        if (dir == 0) { sx = l128 * c0.x + c1.x; sy = l128 * c0.y + c1.y; } else { sx = c0.x + l128 * c1.x; sy = c0.y + l128 * c1.y; }
        for (int k = 0; k < 16; ++k) {
            const int cc = dir ? 15 - k : k;
            *(unsigned*)(ST + (((size_t)bh * 16 + cc) * 2 + dir) * 8192 + e) = cvt_pk_bf16(sx * l1, sy * l1);
            const float2 tv = *(const float2*)(Tb + (size_t)cc * 16384);
            sx = sx * l128 + tv.x; sy = sy * l128 + tv.y;
        }
    }
}
__device__ __forceinline__ void ret_stageC(Frame& F) {
    const int lane = F.lane, w = F.wave, r32 = lane & 31, hi = lane >> 5, half = w >> 2, ib = w & 3;
    const unsigned lds0 = (unsigned)(uintptr_t)F.lds; const LAS char* L = (const LAS char*)F.lds + half * 65536;
    const bf16_t* QF = (const bf16_t*)(F.ws + WS_QF); const bf16_t* QB = (const bf16_t*)(F.ws + WS_QB); const bf16_t* KF = (const bf16_t*)(F.ws + WS_KF); const bf16_t* KB = (const bf16_t*)(F.ws + WS_KB);
    const bf16_t* V1 = (const bf16_t*)(F.ws + WS_V1); const bf16_t* G1 = (const bf16_t*)(F.ws + WS_G1); const bf16_t* ST = (const bf16_t*)(F.ws + WS_ST); bf16_t* A6 = (bf16_t*)(F.ws + WS_ACT);
    for (int pr = F.vcu; pr < 512; pr += F.G) {
        const int u = 2 * pr + half, bh = u >> 4, cc = u & 15, b = bh >> 2, h = bh & 3, row0 = b * 2048 + cc * 128;
        dma_tile(V1 + (size_t)row0 * 512 + h * 128, 512, 128, 256, lds0 + half * 65536, ib, 4, lane);
        dma_tile(ST + ((size_t)u * 2 + 0) * 8192, 128, 64, 256, lds0 + half * 65536 + 32768, ib, 4, lane);
        dma_tile(ST + ((size_t)u * 2 + 1) * 8192, 128, 64, 256, lds0 + half * 65536 + 49152, ib, 4, lane);
        const size_t qoff = (size_t)(row0 + 32 * ib + r32) * 256 + h * 64 + hi * 8;
        bf16x8 qf[4], qb[4];
#pragma unroll
        for (int d0 = 0; d0 < 4; ++d0) { qf[d0] = *(const bf16x8*)(QF + qoff + 16 * d0); qb[d0] = *(const bf16x8*)(QB + qoff + 16 * d0); }
        f32x16 o[4];
#pragma unroll
        for (int vb = 0; vb < 4; ++vb)
#pragma unroll
            for (int r = 0; r < 16; ++r) o[vb][r] = 0.f;
        WAIT_BAR(0);
#pragma unroll
        for (int s = 0; s < 4; ++s)
#pragma unroll
            for (int vb = 0; vb < 4; ++vb) {
                o[vb] = MFMA32(qf[s], tr_frag<0>(L + 32768, 256, 16 * s, 32 * vb, lane), o[vb]);
                o[vb] = MFMA32(qb[s], tr_frag<0>(L + 49152, 256, 16 * s, 32 * vb, lane), o[vb]);
            }
        const int iq = 32 * ib + r32;
#pragma unroll 1
        for (int jb = 0; jb < 4; ++jb) {
            const size_t koff = (size_t)(row0 + 32 * jb + r32) * 256 + h * 64 + hi * 8;
            f32x16 pf, pb;
#pragma unroll
            for (int r = 0; r < 16; ++r) { pf[r] = 0.f; pb[r] = 0.f; }
#pragma unroll
            for (int d0 = 0; d0 < 4; ++d0) { pf = MFMA32(*(const bf16x8*)(KF + koff + 16 * d0), qf[d0], pf); pb = MFMA32(*(const bf16x8*)(KB + koff + 16 * d0), qb[d0], pb); }
            float pp[16];
#pragma unroll
            for (int r = 0; r < 16; ++r) { const int j = 32 * jb + crow(r, hi); pp[r] = (j <= iq ? pf[r] : 0.f) + (j >= iq ? pb[r] : 0.f); }
            u32x4 pw0, pw1;
#pragma unroll
            for (int i = 0; i < 4; ++i) { pw0[i] = cvt_pk_bf16(pp[2 * i], pp[2 * i + 1]); pw1[i] = cvt_pk_bf16(pp[8 + 2 * i], pp[9 + 2 * i]); }
#pragma unroll
            for (int vb = 0; vb < 4; ++vb) {
                o[vb] = MFMA32(as_bf16x8(pw0), tr_frag<1>(L, 256, 32 * jb, 32 * vb, lane), o[vb]);
                o[vb] = MFMA32(as_bf16x8(pw1), tr_frag<1>(L, 256, 32 * jb + 16, 32 * vb, lane), o[vb]);
            }
        }
        asm volatile("s_waitcnt lgkmcnt(0)" ::: "memory"); __builtin_amdgcn_s_barrier(); asm volatile("" ::: "memory");
        LAS float* OS = (LAS float*)(F.lds + half * 65536 + ib * 16384);
#pragma unroll
        for (int vb = 0; vb < 4; ++vb)
#pragma unroll
            for (int r = 0; r < 16; ++r) OS[crow(r, hi) * 128 + ((32 * vb + r32) ^ (4 * (crow(r, hi) & 7)))] = o[vb][r];
        asm volatile("s_waitcnt lgkmcnt(0)" ::: "memory");
        const int row = lane >> 1, hf = lane & 1;
        f32x4 v[16]; float ss = 0.f;
#pragma unroll
        for (int i = 0; i < 16; ++i) { v[i] = *(const LAS f32x4*)(OS + row * 128 + ((64 * hf + 4 * i) ^ (4 * (row & 7)))); ss += (v[i][0] * v[i][0] + v[i][1] * v[i][1]) + (v[i][2] * v[i][2] + v[i][3] * v[i][3]); }
        ss += __shfl_xor(ss, 1);
        const float ri = rsqrtf(ss * (1.f / 128.f) + 1e-6f);
        const size_t orow = (size_t)(row0 + 32 * ib + row);
        const bf16_t* gp = G1 + orow * 512 + h * 128 + 64 * hf; bf16_t* op = A6 + orow * 1024 + 512 + h * 128 + 64 * hf; const float* gn = F.in[24] + 64 * hf;
#pragma unroll
        for (int i = 0; i < 8; ++i) {
            const u32x4 gg = *(const u32x4*)(gp + 8 * i);
            const f32x4 g0 = *(const f32x4*)(gn + 8 * i), g1 = *(const f32x4*)(gn + 8 * i + 4);
            f32x4 a = v[2 * i] * ri * g0, c = v[2 * i + 1] * ri * g1;
            a[0] *= bf_lo(gg[0]); a[1] *= bf_hi(gg[0]); a[2] *= bf_lo(gg[1]); a[3] *= bf_hi(gg[1]); c[0] *= bf_lo(gg[2]); c[1] *= bf_hi(gg[2]); c[2] *= bf_lo(gg[3]); c[3] *= bf_hi(gg[3]);
            *(u32x4*)(op + 8 * i) = pack8(a, c);
        }
        asm volatile("s_waitcnt lgkmcnt(0)" ::: "memory"); __builtin_amdgcn_s_barrier(); asm volatile("" ::: "memory");
    }
}
}
namespace mk {
constexpr int N_PHASES = 17;
__global__ void __launch_bounds__(512, 2) fwd_megakernel(Args args) {
    extern __shared__ __attribute__((aligned(16))) unsigned char lds_raw[];
    Frame F;
    F.lds = (LAS unsigned char*)lds_raw;
    F.tid = threadIdx.x; F.lane = F.tid & 63; F.wave = __builtin_amdgcn_readfirstlane(F.tid >> 6);
    F.G = gridDim.x; { const int bx = blockIdx.x; F.vcu = (F.G % 8 == 0) ? (bx % 8) * (F.G / 8) + bx / 8 : bx; }
    F.in = args.in; F.out = args.out; F.ws = args.ws;
    volatile LAS unsigned* MISC = (volatile LAS unsigned*)(F.lds + MISC_OFF);
    for (int u = F.tid; u < 128; u += 512) MISC[u] = 0u;
    __syncthreads();
    XcdBarrier bar = xcd_barrier_post((unsigned*)(F.ws + WS_CTL) + CW_BAR, MISC + 8);
    const int lo = args.ph_lo, hi = args.ph_hi;
#define IN(k) (lo <= (k) && (k) < hi)
#define SEAM(k) do { if (IN(k) && IN((k) + 1)) xcd_barrier(bar); } while (0)
    float* MOD = (float*)(F.ws + WS_MOD);
    float* XC = (float*)(F.ws + WS_XC);
    bf16_t* ACT = (bf16_t*)(F.ws + WS_ACT);
    LAS unsigned char* ring = F.lds;

    if (IN(0)) p0_prologue(F);
    SEAM(0);
    if (IN(1)) norm_pass(F, F.in[0], F.in[2], NTOK, F.in[6], MOD, 0);
    SEAM(1);
    if (IN(2)) {
        pg8::Gemm g{ACT, (const bf16_t*)(F.ws + WS_WIN0), 1024, 256L * 1024 * 2}; pg8::StaticOrder S; S.init(144, 12, F.G, (int)blockIdx.x);
        EpiIn0 E{F.ws, F.in[11], F.in[12]};
        pg8::gemm_phase(ring, g, S, E);
    }
    SEAM(2);
    if (IN(3)) { attn_phase(F); convgate_pass(F); }
    SEAM(3);
    if (IN(4)) {
        pg8::Gemm g{ACT, (const bf16_t*)(F.ws + WS_WOUT0), 1024, 256L * 1024 * 2}; pg8::StaticOrder S; S.init(144, 4, F.G, (int)blockIdx.x);
        EpiRes E{F.in[0], F.in[2], F.out, XC, MOD, 2048};
        pg8::gemm_phase(ring, g, S, E);
    }
    SEAM(4);
    if (IN(5)) norm_pass(F, F.out, XC, NTOK, F.in[7], MOD, 3072);
    SEAM(5);
    if (IN(6)) {
        pg8::Gemm g{ACT - 1024, (const bf16_t*)(F.ws + WS_WUP0), 1024, 254L * 1024 * 2}; pg8::StaticOrder S; S.init(146, 22, F.G, (int)blockIdx.x);
        EpiUp E{(bf16_t*)(F.ws + WS_HACT), F.in[26], F.in[27], NTOK, (LAS float*)(F.lds + SIDE_OFF)};
        pg8::gemm_phase(ring, g, S, E);
    }
    SEAM(6);
    if (IN(7)) {
        pg8::Gemm g{(const bf16_t*)(F.ws + WS_HACT), (const bf16_t*)(F.ws + WS_WDN0), FF, 256L * FF * 2}; pg8::StaticOrder S; S.init(144, 4, F.G, (int)blockIdx.x);
        EpiRes E{F.out, XC, F.out, XC, MOD, 5120};
        pg8::gemm_phase(ring, g, S, E);
    }
    SEAM(7);
    if (IN(8)) norm_pass(F, F.out, XC, NTOK, F.in[6] + 1024, MOD + 17 * 6144, 0);
    SEAM(8);
    if (IN(9)) {
        pg8::Gemm g{ACT, (const bf16_t*)(F.ws + WS_WIN1), 1024, 256L * 1024 * 2}; OrderIn1 S; S.init(F.G, (int)blockIdx.x);
        EpiIn1 E{F.ws, F.in[22], F.in[23]};
        pg8::gemm_phase(ring, g, S, E);
    }
    SEAM(9);
    if (IN(10)) { ret_stageA(F); pool_pass(F); }
    SEAM(10);
    if (IN(11)) ret_scan(F);
    SEAM(11);
    if (IN(12)) ret_stageC(F);
    SEAM(12);
    if (IN(13)) {
        pg8::Gemm g{ACT, (const bf16_t*)(F.ws + WS_WOUT1), 1024, 256L * 1024 * 2}; pg8::StaticOrder S; S.init(128, 4, F.G, (int)blockIdx.x);
        EpiRes E{F.out, XC, F.out, XC, MOD + 17 * 6144, 2048};
        pg8::gemm_phase(ring, g, S, E);
    }
    SEAM(13);
    if (IN(14)) norm_pass(F, F.out, XC, NL, F.in[7] + 1024, MOD + 17 * 6144, 3072);
    SEAM(14);
    if (IN(15)) {
        pg8::Gemm g{ACT - 1024, (const bf16_t*)(F.ws + WS_WUP1), 1024, 254L * 1024 * 2}; pg8::StaticOrder S; S.init(130, 22, F.G, (int)blockIdx.x);
        EpiUp E{(bf16_t*)(F.ws + WS_HACT), F.in[26] + 3 * FF, F.in[27] + FF, NL, (LAS float*)(F.lds + SIDE_OFF)};
        pg8::gemm_phase(ring, g, S, E);
    }
    SEAM(15);
    if (IN(16)) {
        pg8::Gemm g{(const bf16_t*)(F.ws + WS_HACT), (const bf16_t*)(F.ws + WS_WDN1), FF, 256L * FF * 2}; pg8::StaticOrder S; S.init(128, 4, F.G, (int)blockIdx.x);
        EpiRes E{F.out, XC, F.out, XC, MOD + 17 * 6144, 5120};
        pg8::gemm_phase(ring, g, S, E);
    }
#undef IN
#undef SEAM
}

static int g_grid = 0;
inline void launch(hipStream_t stream, void* const* d_in, void* d_out, void* d_ws, int ph_lo, int ph_hi) {
    if (g_grid == 0) {
        int dev = 0, cus = 0, per_cu = 0;
        (void)hipGetDevice(&dev); (void)hipDeviceGetAttribute(&cus, hipDeviceAttributeMultiprocessorCount, dev);
        (void)hipFuncSetAttribute((const void*)fwd_megakernel, hipFuncAttributeMaxDynamicSharedMemorySize, LDS_BYTES);
        (void)hipOccupancyMaxActiveBlocksPerMultiprocessor(&per_cu, (const void*)fwd_megakernel, 512, LDS_BYTES);
        (void)hipGetLastError();
        if (per_cu < 1) fprintf(stderr, "kernel_launch: occupancy query reports %d blocks per CU\n", per_cu);
        g_grid = cus > 0 ? cus : 256;
    }
    (void)hipMemsetAsync((char*)d_ws + WS_CTL, 0, CTL_ZERO_BYTES, stream);
    Args a{};
    for (int i = 0; i < 29; ++i) a.in[i] = (const float*)d_in[i];
    a.out = (float*)d_out; a.ws = (unsigned char*)d_ws; a.ph_lo = ph_lo; a.ph_hi = ph_hi;
    hipLaunchKernelGGL(fwd_megakernel, dim3(g_grid), dim3(512), LDS_BYTES, stream, a);
}
}
extern "C" void kernel_launch(void* const* d_in, const int* in_sizes, int n_in, void* d_out, int out_size, void* d_ws, size_t ws_size, hipStream_t stream) {
    mk::launch(stream, d_in, d_out, d_ws, 0, mk::N_PHASES);
}
```

```cpp
#include <hip/hip_runtime.h>
#include <cstdio>
#include <cstdint>
#include <cstring>

#define LAS __attribute__((address_space(3)))
#define GAS __attribute__((address_space(1)))
typedef unsigned short bf16_t;
typedef short bf16x8 __attribute__((ext_vector_type(8)));
typedef short s16x4 __attribute__((ext_vector_type(4)));
typedef float f32x4 __attribute__((ext_vector_type(4)));
typedef float f32x16 __attribute__((ext_vector_type(16)));
typedef unsigned u32x4 __attribute__((ext_vector_type(4)));
typedef unsigned u32x2 __attribute__((ext_vector_type(2)));
typedef GAS unsigned gu32;

__device__ __forceinline__ unsigned cvt_pk_bf16(float lo, float hi) { unsigned r; asm volatile("v_cvt_pk_bf16_f32 %0, %1, %2" : "=v"(r) : "v"(lo), "v"(hi)); return r; }
__device__ __forceinline__ float bf_lo(unsigned u) { return __uint_as_float(u << 16); }
__device__ __forceinline__ float bf_hi(unsigned u) { return __uint_as_float(u & 0xffff0000u); }
__device__ __forceinline__ float fast_silu(float v) { return v * __builtin_amdgcn_rcpf(1.f + __builtin_amdgcn_exp2f(-1.4426950408889634f * v)); }
__device__ __forceinline__ float wave_sum(float v) {
#pragma unroll
    for (int o = 1; o < 64; o <<= 1) v += __shfl_xor(v, o);
    return v;
}
__device__ __forceinline__ float wave_max(float v) {
#pragma unroll
    for (int o = 1; o < 64; o <<= 1) v = fmaxf(v, __shfl_xor(v, o));
    return v;
}
__device__ __forceinline__ void glds16(const void* gsrc, unsigned lds_dst) {
    unsigned keep;
    asm volatile("s_mov_b32 %0, m0\n\ts_mov_b32 m0, %2\n\ts_nop 0\n\tglobal_load_lds_dwordx4 %1, off\n\ts_mov_b32 m0, %0" : "=&s"(keep) : "v"(gsrc), "s"(lds_dst) : "memory");
}
#define WAIT_BAR(N) asm volatile("s_waitcnt vmcnt(" #N ") lgkmcnt(0)\n\ts_barrier" ::: "memory")
typedef short v4i16_t __attribute__((ext_vector_type(4)));
__device__ __forceinline__ s16x4 tr_read(const LAS char* p) { return __builtin_bit_cast(s16x4, __builtin_amdgcn_ds_read_tr16_b64_v4i16((LAS v4i16_t*)p)); }
__device__ __forceinline__ bf16x8 cat8(s16x4 lo, s16x4 hi) { return (bf16x8){lo[0], lo[1], lo[2], lo[3], hi[0], hi[1], hi[2], hi[3]}; }
__device__ __forceinline__ int crow(int r, int hi) { return (r & 3) + 8 * (r >> 2) + 4 * hi; }

namespace pg8 {
constexpr int BM = 256, BK = 64, HALF = 128, HTB = HALF * BK * 2  , STAGE_BYTES = 8 * HTB, NXCD = 8, WGM = 8;
__host__ __device__ __forceinline__ int lds_byte(int r, int c) { const int st = (r >> 4) * 2 + (c >> 5), rr = r & 15, cc = c & 31, ob = rr * 64 + cc * 2; return st * 1024 + (ob ^ (((ob >> 9) & 1) << 5)); }
__host__ __device__ __forceinline__ void stage_rc(int b, int& R, int& C) { const int st = b / 1024, sb = b % 1024, swz = sb ^ (((sb >> 9) & 1) << 5); R = (st >> 1) * 16 + swz / 64; C = (st & 1) * 32 + (swz % 64) / 2; }

struct Unit { int pm, pn; };
struct Gemm { const bf16_t* A; const bf16_t* Bt; int K; long a_tstep; };

struct StaticOrder {
    int nM, nN, nwg, G, c;
    __device__ void init(int nM_, int nN_, int G_, int c_) { nM = nM_; nN = nN_; nwg = nM * nN; G = G_; c = c_; }
    __device__ bool next(int i, Unit& u) const { return at((long)i * G + c, u); }
    __device__ bool at(long L, Unit& u) const {
        if (L >= nwg) return false;
        int wgid = (int)L; { const int q = nwg / NXCD, r = nwg % NXCD, xcd = wgid % NXCD, off = wgid / NXCD; wgid = (xcd < r ? xcd * (q + 1) : r * (q + 1) + (xcd - r) * q) + off; }
        const int nig = WGM * nN, gid = wgid / nig, fm = gid * WGM, gsz = (nM - fm) < WGM ? (nM - fm) : WGM;
        u.pm = fm + ((wgid % nig) % gsz); u.pn = (wgid % nig) / gsz; return true;
    }
};

struct DealOrder {
    StaticOrder so; int G, c, skipC, skipR;
    __device__ void init(int nM, int nN, int G_, int c_, int skipC_, int skipR_) { so.init(nM, nN, G_, c_); G = G_; c = c_; skipC = skipC_; skipR = skipR_; }
    __device__ bool next(int i, Unit& u) const {
        long L;
        if (c < skipC) L = (long)skipR * (G - skipC) + (long)i * G + c;
        else L = i < skipR ? (long)i * (G - skipC) + (c - skipC) : (long)skipR * (G - skipC) + (long)(i - skipR) * G + c;
        return so.at(L, u);
    }
};
struct ListOrder {
    int G, c, pm0, pn0, npn, count;
    __device__ bool next(int i, Unit& u) const { const int e = i * G + c; if (e >= count) return false; u.pm = pm0 + e / npn; u.pn = pn0 + e % npn; return true; }
};
template <class Epi, class Sched>
__device__ __forceinline__ void gemm_phase(LAS unsigned char* lds, const Gemm g, const Sched& S, const Epi& E) {
    const int tid = threadIdx.x, wid = __builtin_amdgcn_readfirstlane(tid >> 6), lane = tid & 63, wr = wid >> 2, wc = wid & 3, fr = lane & 15, fq = lane >> 4;
    const int K = g.K, nt = K / BK;
    unsigned voffA[2];
#pragma unroll
    for (int i = 0; i < 2; ++i) { int R, C; stage_rc(tid * 16 + i * 8192, R, C); voffA[i] = (unsigned)(R * K + C) * 2u; }
    const size_t kstep = (size_t)(BK * 2);
    const size_t hstep = (size_t)HALF * K * 2;
    const size_t btstep = 2 * hstep;
    const unsigned ldsw = (unsigned)wid * 1024u;
    const int aoff = lds_byte(wr * 64 + fr, fq * 8), boff = lds_byte(wc * 32 + fr, fq * 8);
#define PG8_SA(b, h) (((b) * 2 + (h)) * HTB)
#define PG8_SB(b, h) ((4 + (b) * 2 + (h)) * HTB)
#define PG8_STAGE(bufoff, gbase) do { _Pragma("unroll") for (int _i = 0; _i < 2; ++_i) \
        __builtin_amdgcn_global_load_lds((const unsigned*)((const char*)(gbase) + voffA[_i]), (LAS unsigned*)(lds + (bufoff) + ldsw + _i * 8192), 16, 0, 0); } while (0)
#define PG8_LDA(dst, b, h) do { _Pragma("unroll") for (int m = 0; m < 4; ++m) _Pragma("unroll") for (int k = 0; k < 2; ++k) dst[m][k] = *(const LAS bf16x8*)(lds + PG8_SA(b, h) + aoff + m * 2048 + k * 1024); } while (0)
#define PG8_LDB(dst, b, h) do { _Pragma("unroll") for (int n = 0; n < 2; ++n) _Pragma("unroll") for (int k = 0; k < 2; ++k) dst[n][k] = *(const LAS bf16x8*)(lds + PG8_SB(b, h) + boff + n * 2048 + k * 1024); } while (0)
#define PG8_MMA(ai, bj, At, Bt) do { __builtin_amdgcn_s_setprio(1); _Pragma("unroll") for (int m = 0; m < 4; ++m) _Pragma("unroll") for (int n = 0; n < 2; ++n) _Pragma("unroll") for (int k = 0; k < 2; ++k) \
        acc[ai][bj][m][n] = __builtin_amdgcn_mfma_f32_16x16x32_bf16(Bt[n][k], At[m][k], acc[ai][bj][m][n], 0, 0, 0); __builtin_amdgcn_s_setprio(0); } while (0)
#define PG8_WAIT_V(n) asm volatile("s_waitcnt vmcnt(" #n ")" ::: "memory")
#define PG8_WAIT_L(n) asm volatile("s_waitcnt lgkmcnt(" #n ")" ::: "memory")
#define PG8_BAR __builtin_amdgcn_s_barrier()
#define PG8_SCHED __builtin_amdgcn_sched_barrier(0)
    LAS int* utab = (LAS int*)(lds + STAGE_BYTES + 12288);
    if (tid < 32) { Unit t_; const bool ok_ = S.next(tid, t_); utab[2 * tid] = ok_ ? t_.pm : -1; utab[2 * tid + 1] = ok_ ? t_.pn : 0; }
    asm volatile("s_waitcnt lgkmcnt(0)" ::: "memory"); __builtin_amdgcn_s_barrier(); asm volatile("" ::: "memory");
#define PG8_UNIT(i, U) ((U).pm = __builtin_amdgcn_readfirstlane(utab[2 * (i)]), (U).pn = __builtin_amdgcn_readfirstlane(utab[2 * (i) + 1]), (U).pm >= 0)
    Unit cur, nxt; int ui = 0;
    if (!PG8_UNIT(0, cur)) return;
    const char* pfb = nullptr;
    if constexpr (Epi::PF) pfb = E.pf_base(cur) + (size_t)wid * 4096 + lane * 16;
#define PG8_PF(it_, sp_) do { if constexpr (Epi::PF) { int pi_ = (it_) * 4 + (sp_); pi_ = pi_ > 31 ? 31 : pi_; \
        __builtin_amdgcn_global_load_lds((const unsigned*)(pfb + (size_t)pi_ * 32768), (LAS unsigned*)(lds + STAGE_BYTES + ldsw), 16, 0, 0); } } while (0)
#define PG8_WAIT_VK(first_) do { if constexpr (Epi::PF) { if (first_) { PG8_WAIT_V(9); } else { PG8_WAIT_V(10); } } else { PG8_WAIT_V(8); } } while (0)
    f32x4 acc[2][2][4][2];
#pragma unroll
    for (int a = 0; a < 2; ++a)
#pragma unroll
        for (int b = 0; b < 2; ++b)
#pragma unroll
            for (int m = 0; m < 4; ++m)
#pragma unroll
                for (int n = 0; n < 2; ++n) acc[a][b][m][n] = (f32x4){0.f, 0.f, 0.f, 0.f};
    bf16x8 At[4][2], B0[2][2], B1[2][2];
    const char* cA = (const char*)g.A + (long)cur.pm * g.a_tstep; const char* cB = (const char*)g.Bt + (size_t)cur.pn * btstep;
    PG8_STAGE(PG8_SB(0, 0), cB); PG8_STAGE(PG8_SB(0, 1), cB + hstep); PG8_STAGE(PG8_SA(0, 0), cA); PG8_STAGE(PG8_SA(0, 1), cA + hstep);
    if (wr == 1) PG8_BAR;
    PG8_WAIT_V(2); PG8_BAR;
    PG8_STAGE(PG8_SB(1, 0), cB + kstep); PG8_STAGE(PG8_SA(1, 0), cA + kstep); PG8_STAGE(PG8_SB(1, 1), cB + hstep + kstep);
    PG8_WAIT_V(6); PG8_BAR;
    for (;;) {
        const bool has_next = PG8_UNIT(ui + 1, nxt);
        const char* nA = has_next ? (const char*)g.A + (long)nxt.pm * g.a_tstep : cA; const char* nB = has_next ? (const char*)g.Bt + (size_t)nxt.pn * btstep : cB;
        for (int t = 0; t < nt; t += 2) {
            const bool last = (t == nt - 2);
            const char* a1 = cA + (size_t)(t + 1) * kstep;
            const char* a2 = last ? nA : cA + (size_t)(t + 2) * kstep; const char* b2 = last ? nB : cB + (size_t)(t + 2) * kstep;
            const char* a3 = a2 + kstep; const char* b3 = b2 + kstep;
            const int it2 = t >> 1;
            PG8_LDB(B0, 0, 0); PG8_LDB(B1, 0, 1); PG8_SCHED; PG8_LDA(At, 0, 0); PG8_STAGE(PG8_SA(1, 1), a1 + hstep); PG8_PF(it2, 0);
            PG8_WAIT_VK(ui == 0 && t == 0); PG8_WAIT_L(0); PG8_BAR; PG8_MMA(0, 0, At, B0); PG8_MMA(0, 1, At, B1); PG8_BAR; PG8_SCHED;
            PG8_LDA(At, 0, 1); PG8_STAGE(PG8_SB(0, 0), b2); PG8_STAGE(PG8_SB(0, 1), b2 + hstep); PG8_STAGE(PG8_SA(0, 0), a2); PG8_PF(it2, 1);
            PG8_WAIT_VK(false); PG8_WAIT_L(0); PG8_BAR; PG8_MMA(1, 0, At, B0); PG8_MMA(1, 1, At, B1); PG8_BAR; PG8_SCHED;
            PG8_LDB(B0, 1, 0); PG8_LDB(B1, 1, 1); PG8_SCHED; PG8_LDA(At, 1, 0); PG8_STAGE(PG8_SA(0, 1), a2 + hstep); PG8_PF(it2, 2);
            PG8_WAIT_VK(false); PG8_WAIT_L(0); PG8_BAR; PG8_MMA(0, 0, At, B0); PG8_MMA(0, 1, At, B1); PG8_BAR; PG8_SCHED;
            PG8_LDA(At, 1, 1); PG8_STAGE(PG8_SB(1, 0), b3); PG8_STAGE(PG8_SB(1, 1), b3 + hstep); PG8_STAGE(PG8_SA(1, 0), a3); PG8_PF(it2, 3);
            PG8_WAIT_VK(false); PG8_WAIT_L(0); PG8_BAR; PG8_MMA(1, 0, At, B0); PG8_MMA(1, 1, At, B1); PG8_BAR; PG8_SCHED;
        }
        if (wr == 0) PG8_BAR;
        E(acc, cur, wr, wc, fr, fq);
        if (!has_next) break;
#pragma unroll
        for (int a = 0; a < 2; ++a)
#pragma unroll
            for (int b = 0; b < 2; ++b)
#pragma unroll
                for (int m = 0; m < 4; ++m)
#pragma unroll
                    for (int n = 0; n < 2; ++n) acc[a][b][m][n] = (f32x4){0.f, 0.f, 0.f, 0.f};
        cur = nxt; cA = nA; cB = nB; ++ui;
        if constexpr (Epi::PF) pfb = E.pf_base(cur) + (size_t)wid * 4096 + lane * 16;
        if (wr == 1) PG8_BAR;
    }
    PG8_WAIT_V(0);
    PG8_BAR;
#undef PG8_UNIT
#undef PG8_PF
#undef PG8_WAIT_VK
#undef PG8_SA
#undef PG8_SB
#undef PG8_STAGE
#undef PG8_LDA
#undef PG8_LDB
#undef PG8_MMA
#undef PG8_WAIT_V
#undef PG8_WAIT_L
#undef PG8_BAR
#undef PG8_SCHED
}
}

#define XB_TMO      128
#define XB_XCNT(j)  (256  + 64 * (j))
#define XB_XSUB(j)  (1280 + 64 * (j))
#define XB_XGEN(j)  (2304 + 64 * (j))
#define XB_TOP      3328
#define XB_TOPGEN   3392
#define XCD_BAR_WORDS 3456
#define XB_SPIN_CAP (1u << 18)
__device__ __forceinline__ unsigned xb_ld(unsigned* p)              { return __hip_atomic_load(p, __ATOMIC_RELAXED, __HIP_MEMORY_SCOPE_AGENT); }
__device__ __forceinline__ unsigned xb_add(unsigned* p, unsigned v) { return __hip_atomic_fetch_add(p, v, __ATOMIC_RELAXED, __HIP_MEMORY_SCOPE_AGENT); }
__device__ __forceinline__ unsigned xb_xcc_id() { return (unsigned)__builtin_amdgcn_s_getreg((3 << 11) | 20) & 0xFu; }
#define XB_SPIN(cond, bar) do { unsigned _sp = 0; while (cond) { __builtin_amdgcn_s_sleep(1); \
    if ((++_sp & 255u) == 0u) { if (xb_ld(&(bar)[XB_TMO])) break; if (_sp > XB_SPIN_CAP) { atomicAdd(&(bar)[XB_TMO], 1u); break; } } } } while (0)
struct XcdBarrier { unsigned* bar; unsigned x; volatile LAS unsigned* st; };
__device__ __forceinline__ XcdBarrier xcd_barrier_post(unsigned* bar, volatile LAS unsigned* st) {
    XcdBarrier b; b.bar = bar; b.x = xb_xcc_id(); b.st = st;
    if (threadIdx.x == 0) (void)xb_add(&bar[XB_XCNT(b.x)], 1u);
    return b;
}
__device__ __forceinline__ void xcd_barrier_complete(unsigned* bar, unsigned x, unsigned& nloc, unsigned& nx) {
    const unsigned G = gridDim.x * gridDim.y * gridDim.z;
    unsigned sum, cnt, mine, sp = 0u;
    for (;;) {
        sum = 0u; cnt = 0u; mine = 0u;
#pragma unroll
        for (unsigned j = 0; j < 16; ++j) { const unsigned c = xb_ld(&bar[XB_XCNT(j)]); sum += c; cnt += (c > 0u) ? 1u : 0u; mine = (j == x) ? c : mine; }
        if (sum == G) break;
        __builtin_amdgcn_s_sleep(1);
        if ((++sp & 255u) == 0u) { if (xb_ld(&bar[XB_TMO])) break; if (sp > XB_SPIN_CAP) { atomicAdd(&bar[XB_TMO], 1u); break; } }
    }
    nloc = mine > 0u ? mine : 1u; nx = cnt > 0u ? cnt : 1u;
}
__device__ __forceinline__ void xcd_barrier(const XcdBarrier& b) {
    asm volatile("s_waitcnt vmcnt(0)" ::: "memory");
    __syncthreads();
    if (threadIdx.x == 0) {
        unsigned* bar = b.bar;
        __builtin_amdgcn_s_waitcnt(0);
        unsigned nloc = b.st[0], nx = b.st[1];
        if (nloc == 0u) { xcd_barrier_complete(bar, b.x, nloc, nx); b.st[0] = nloc; b.st[1] = nx; }
        const unsigned old = xb_add(&bar[XB_XSUB(b.x)], 1u);
        const unsigned gen = old / nloc;
        if (old + 1u == (gen + 1u) * nloc) {
            __builtin_amdgcn_fence(__ATOMIC_RELEASE, "agent");
            asm volatile("s_waitcnt vmcnt(0)" ::: "memory");
            const unsigned og = xb_add(&bar[XB_TOP], 1u);
            const unsigned tg = og / nx;
            if (og + 1u == (tg + 1u) * nx) xb_add(&bar[XB_TOPGEN], 1u);
            else XB_SPIN(xb_ld(&bar[XB_TOPGEN]) == tg, bar);
            __builtin_amdgcn_fence(__ATOMIC_ACQUIRE, "agent");
            xb_add(&bar[XB_XGEN(b.x)], 1u);
            asm volatile("s_waitcnt vmcnt(0)" ::: "memory");
        } else {
            XB_SPIN(xb_ld(&bar[XB_XGEN(b.x)]) == gen, bar);
            __builtin_amdgcn_fence(__ATOMIC_ACQUIRE, "agent");
            asm volatile("s_waitcnt vmcnt(0)" ::: "memory");
        }
    }
    __syncthreads();
}
#ifdef MK_TS
#define MK_STAMP2(k) do { if (blockIdx.x == 0 && threadIdx.x == 0) ((unsigned long long*)(F.ws + 524288))[k] = __builtin_amdgcn_s_memrealtime(); } while (0)
#else
#define MK_STAMP2(k) do { } while (0)
#endif
namespace mk {
constexpr int NL = 32768, NC = 4096, NTOK = NL + NC, D = 1024, FF = 2816;
constexpr size_t MiB = 1u << 20;
constexpr size_t WS_CTL = 0, CTL_ZERO_BYTES = 1 * MiB;
constexpr size_t WS_MOD = 1 * MiB;
constexpr size_t WS_ROPE = 2 * MiB;
constexpr size_t WS_WIN0 = 4 * MiB, WS_WOUT0 = 10 * MiB, WS_WIN1 = 12 * MiB, WS_WOUT1 = 16 * MiB, WS_WUP0 = 18 * MiB, WS_WUP1 = 29 * MiB, WS_WDN0 = 40 * MiB, WS_WDN1 = 46 * MiB;
constexpr size_t WS_ACT = 56 * MiB + 2048;
constexpr size_t WS_XC = 132 * MiB;
constexpr size_t WS_BIG = 150 * MiB;
constexpr size_t WS_BG = WS_BIG, WS_U = WS_BIG + 36 * MiB, WS_Q = WS_BIG + 72 * MiB, WS_K = WS_BIG + 108 * MiB, WS_V = WS_BIG + 144 * MiB;
constexpr size_t WS_HACT = WS_BIG;
constexpr size_t WS_PV = WS_BIG, WS_QF = WS_BIG + 32 * MiB, WS_QB = WS_BIG + 48 * MiB, WS_KF = WS_BIG + 64 * MiB, WS_KB = WS_BIG + 82 * MiB, WS_V1 = WS_BIG + 100 * MiB, WS_G1 = WS_BIG + 136 * MiB;
constexpr size_t WS_ST = WS_BIG + 168 * MiB;
constexpr size_t WS_ACT2 = 352 * MiB + 2048;
constexpr size_t WS_SS = 426 * MiB, SS_STRIDE = 5 * MiB / 2;
constexpr size_t WS_BIAS = 434 * MiB;
constexpr size_t BIAS_BU0 = 0, BIAS_BI1 = 17 * 5632 * 4, BIAS_BU1 = BIAS_BI1 + 17 * 2048 * 4;
constexpr size_t WS_END = 436 * MiB;
static_assert(WS_END <= 512 * MiB, "d_ws map");
constexpr int CW_BAR = 4096;
constexpr int RING_BYTES = 131072, SIDE_OFF = RING_BYTES, SIDE_BYTES = 16384, MISC_OFF = SIDE_OFF + SIDE_BYTES, LDS_BYTES = MISC_OFF + 512;

struct Args { const float* in[29]; float* out; unsigned char* ws; int ph_lo, ph_hi; };

struct Frame {
    LAS unsigned char* lds;
    int tid, lane, wave, vcu, G;
    const float* const* in; float* out; unsigned char* ws;
};

__device__ __forceinline__ int plain8(int tc) { const int bj = tc >> 7, wc = (tc >> 5) & 3, n = (tc >> 4) & 1, fq = (tc >> 2) & 3, j = tc & 3; return 128 * bj + 32 * wc + 8 * fq + 4 * n + j; }
__device__ __forceinline__ int head64(int tc) { const int bj = tc >> 7, n = (tc >> 4) & 1, fq = (tc >> 2) & 3, j = tc & 3; return 32 * (fq >> 1) + 16 * bj + 8 * (fq & 1) + 4 * n + j; }
enum { SG_ID = 0, SG_IN0 = 1, SG_UP = 2, SG_IN1 = 3, SG_P8 = 4 };
__device__ __forceinline__ int inv_plain8(int c) { const int hi3 = c & ~31, fq = (c >> 3) & 3, n = (c >> 2) & 1, j = c & 3; return hi3 + 16 * n + 4 * fq + j; }
__device__ __forceinline__ int sigma(int kind, int np) {
    const int pn = np >> 8, tc = np & 255, bj = tc >> 7, wc = (tc >> 5) & 3;
    if (kind == SG_IN0) {
        if (pn < 2) return 256 * pn + plain8(tc);
        if (pn < 6) return (bj ? 1024 : 512) + 128 * (pn - 2) + (plain8(tc) & 127);
        if (pn < 10) return 1536 + 64 * ((pn - 6) * 4 + wc) + head64(tc);
        return 2560 + 256 * (pn - 10) + plain8(tc);
    }
    if (kind == SG_UP) return (bj ? FF : 0) + 128 * pn + (plain8(tc) & 127);
    if (kind == SG_P8) return 256 * pn + plain8(tc);
    if (kind == SG_IN1) {
        if (pn < 2) return 256 * pn + plain8(tc);
        if (pn == 2) return 512 + 64 * wc + head64(tc);
        if (pn == 3) return 768 + 64 * wc + head64(tc);
        if (pn < 6) return 1024 + 256 * (pn - 4) + plain8(tc);
        return 1536 + 256 * (pn - 6) + plain8(tc);
    }
    return np;
}
__device__ __forceinline__ void transpose_item(const float* W, int K, int N, bf16_t* WT, int kind, LAS float* scr, int item, int lane) {
    const int nblk = N / 32, kb = item / nblk, nb = item % nblk, k0 = 64 * kb, n0 = 32 * nb;
    const int cg = lane & 7, kr = lane >> 3;
    const int scol = sigma(kind, n0 + 4 * cg);
    f32x4 v[8];
#pragma unroll
    for (int i = 0; i < 8; ++i) v[i] = *(const f32x4*)(W + (size_t)(k0 + 8 * i + kr) * N + scol);
#pragma unroll
    for (int i = 0; i < 8; ++i) { LAS float* d = scr + (8 * i + kr) * 33 + 4 * cg; d[0] = v[i][0]; d[1] = v[i][1]; d[2] = v[i][2]; d[3] = v[i][3]; }
    asm volatile("s_waitcnt lgkmcnt(0)" ::: "memory");
    const int c = lane & 7;
#pragma unroll
    for (int j = 0; j < 4; ++j) { const int n = (lane >> 3) + 8 * j; const LAS float* s = scr + (8 * c) * 33 + n;
        u32x4 o; o.x = cvt_pk_bf16(s[0 * 33], s[1 * 33]); o.y = cvt_pk_bf16(s[2 * 33], s[3 * 33]); o.z = cvt_pk_bf16(s[4 * 33], s[5 * 33]); o.w = cvt_pk_bf16(s[6 * 33], s[7 * 33]);
        *(u32x4*)(WT + (size_t)(n0 + n) * K + k0 + 8 * c) = o; }
    asm volatile("s_waitcnt lgkmcnt(0)" ::: "memory");
}
__device__ __forceinline__ void poolfold_item(const float* pw, const float* ps, const float* wo, bf16_t* WT, int item, int lane) {
    const int db = item & 15, cb = (item >> 4) & 15, g = item >> 8, d = db * 64 + lane, c0 = cb * 8;
    float acc[8];
#pragma unroll
    for (int i = 0; i < 8; ++i) acc[i] = 0.f;
#pragma unroll 32
    for (int e = 0; e < 128; ++e) {
        const float w = wo[(size_t)(g * 128 + e) * 1024 + d] * ps[g * 128 + e];
#pragma unroll
        for (int i = 0; i < 8; ++i) acc[i] += pw[((size_t)g * 128 + c0 + i) * 128 + e] * w;
    }
    u32x4 o; o.x = cvt_pk_bf16(acc[0], acc[1]); o.y = cvt_pk_bf16(acc[2], acc[3]); o.z = cvt_pk_bf16(acc[4], acc[5]); o.w = cvt_pk_bf16(acc[6], acc[7]);
    *(u32x4*)(WT + (size_t)((d & ~255) + inv_plain8(d & 255)) * 1024 + g * 128 + c0) = o;
}
__device__ __forceinline__ void mod_item(Frame& F, int item) {
    const float* c = F.in[1]; const float* cc = F.in[3]; const float* mw = F.in[4]; const float* mb = F.in[5];
    float* MOD = (float*)(F.ws + WS_MOD);
    const int i = item / 96, cg = item % 96;
    LAS float* sc = (LAS float*)(F.lds);
    LAS float* part = (LAS float*)(F.lds + 81920);
    {
        f32x4 v[9];
#pragma unroll
        for (int i = 0; i < 9; ++i) { const int q = F.tid + 512 * i; v[i] = q < 4096 ? ((const f32x4*)c)[q] : (q < 4352 ? ((const f32x4*)cc)[q - 4096] : (f32x4){0.f, 0.f, 0.f, 0.f}); }
#pragma unroll
        for (int i = 0; i < 9; ++i) { const int q = F.tid + 512 * i; if (q < 4352) { f32x4 o;
#pragma unroll
            for (int j = 0; j < 4; ++j) o[j] = v[i][j] / (1.f + __expf(-v[i][j]));
            *(LAS f32x4*)(sc + 4 * q) = o; } }
    }
    __syncthreads();
    f32x4 acc[17];
#pragma unroll
    for (int r = 0; r < 17; ++r) acc[r] = (f32x4){0.f, 0.f, 0.f, 0.f};
    const int kbeg = F.wave * 128, cgp = F.lane & 15, kr = F.lane >> 4;
    const float* wp = mw + ((size_t)i * 1024 + kbeg + kr) * 6144 + cg * 64 + 4 * cgp;
    const LAS float* sp = sc + kbeg + kr;
#pragma unroll 8
    for (int s4 = 0; s4 < 32; ++s4) {
        const f32x4 w = *(const f32x4*)(wp + (size_t)(4 * s4) * 6144);
#pragma unroll
        for (int r = 0; r < 17; ++r) acc[r] += w * sp[r * 1024 + 4 * s4];
    }
#pragma unroll
    for (int r = 0; r < 17; ++r) {
#pragma unroll
        for (int j = 0; j < 4; ++j) { float v = acc[r][j]; v += __shfl_xor(v, 16); v += __shfl_xor(v, 32); acc[r][j] = v; }
        if (kr == 0) *(LAS f32x4*)(part + (F.wave * 17 + r) * 64 + 4 * cgp) = acc[r];
    }
    __syncthreads();
    for (int e = F.tid; e < 17 * 64; e += 512) { const int r = e >> 6, l = e & 63; float s = mb[i * 6144 + cg * 64 + l];
#pragma unroll
        for (int w = 0; w < 8; ++w) s += part[(w * 17 + r) * 64 + l];
        MOD[((size_t)i * 17 + r) * 6144 + cg * 64 + l] = s; }
    __syncthreads();
}
__device__ __forceinline__ void p0_prologue(Frame& F, int part) {
    LAS float* scr = (LAS float*)(F.lds + F.wave * 16384);
    const int gw = F.vcu * 8 + F.wave, NGW = F.G * 8;
    constexpr int I_IN0 = 16 * 96, I_OUT0 = 16 * 32, I_UP = 16 * 176, I_DN = 44 * 32;
    if (part == 0) {
        for (int it = F.vcu; it < 32; it += F.G) mod_item(F, it);
        MK_STAMP2(20);
        const int nmodw = F.G >= 128 ? 256 : 0;
        for (int it = gw < nmodw ? I_IN0 : gw - nmodw; it < I_IN0; it += NGW - nmodw) transpose_item(F.in[8], 1024, 3072, (bf16_t*)(F.ws + WS_WIN0), SG_IN0, scr, it, F.lane);
        if (F.vcu == F.G - 1) for (int e = F.tid; e < 1024; e += 512) { const int idx = e >> 4, f = e & 15; const float inv = powf(10000.f, -(float)f / 16.f), ang = (float)idx * inv;
            ((float*)(F.ws + WS_ROPE))[e] = cosf(ang); ((float*)(F.ws + WS_ROPE))[1024 + e] = sinf(ang); }
        MK_STAMP2(21);
    } else if (part == 1) {
        for (int it = 32 + F.vcu; it < 192; it += F.G) mod_item(F, it);
    } else {
        constexpr int NITEMS = I_OUT0 + I_UP + I_DN;
        const bool wide = F.G > 160;
        const int nv = wide ? 160 * 8 + (F.G - 160) * 16 : NGW, nrep = (wide && F.vcu >= 160) ? 2 : 1;
        const int v0 = !wide ? gw : (F.vcu < 160 ? gw : 1280 + (F.vcu - 160) * 16 + F.wave);
#pragma unroll 1
        for (int k = 0;; ++k) {
            const int it = nrep == 2 ? v0 + 8 * (k & 1) + nv * (k >> 1) : v0 + nv * k;
            if (it >= NITEMS) break;
            int r = it;
            if (r < I_OUT0) { transpose_item(F.in[9], 1024, 1024, (bf16_t*)(F.ws + WS_WOUT0), SG_P8, scr, r, F.lane); continue; } r -= I_OUT0;
            if (r < I_UP) { transpose_item(F.in[25], 1024, 5632, (bf16_t*)(F.ws + WS_WUP0), SG_UP, scr, r, F.lane); continue; } r -= I_UP;
            transpose_item(F.in[28], FF, 1024, (bf16_t*)(F.ws + WS_WDN0), SG_P8, scr, r, F.lane);
        }
    }
}
__device__ __forceinline__ void weights1_pass(Frame& F, int widx, int nw, int part) {
    LAS float* scr = (LAS float*)(F.lds + F.wave * 16384);
    const int gw = widx * 8 + F.wave, NGW = nw * 8;
    constexpr int I_FOLD = 4 * 16 * 16, I_IN1 = 16 * 64, I_OUT1H = 8 * 32, I_UP = 16 * 176, I_DN = 44 * 32;
    if (part == 0) {
        for (int it = gw; it < I_IN1 + I_UP; it += NGW) {
            if (it < I_IN1) transpose_item(F.in[18], 1024, 2048, (bf16_t*)(F.ws + WS_WIN1), SG_IN1, scr, it, F.lane);
            else transpose_item(F.in[25] + (size_t)1024 * 5632, 1024, 5632, (bf16_t*)(F.ws + WS_WUP1), SG_UP, scr, it - I_IN1, F.lane);
        }
    } else {
        for (int it = gw; it < I_FOLD + I_OUT1H + I_DN; it += NGW) {
            int r = it;
            if (r < I_FOLD) { poolfold_item(F.in[20], F.in[21], F.in[19], (bf16_t*)(F.ws + WS_WOUT1), r, F.lane); continue; } r -= I_FOLD;
            if (r < I_OUT1H) { transpose_item(F.in[19], 1024, 1024, (bf16_t*)(F.ws + WS_WOUT1), SG_P8, scr, r + 8 * 32, F.lane); continue; } r -= I_OUT1H;
            transpose_item(F.in[28] + (size_t)FF * 1024, FF, 1024, (bf16_t*)(F.ws + WS_WDN1), SG_P8, scr, r, F.lane);
        }
    }
}
__device__ __forceinline__ u32x4 pack8(const f32x4 a, const f32x4 b) { u32x4 w; w.x = cvt_pk_bf16(a[0], a[1]); w.y = cvt_pk_bf16(a[2], a[3]); w.z = cvt_pk_bf16(b[0], b[1]); w.w = cvt_pk_bf16(b[2], b[3]); return w; }
__device__ __forceinline__ void norm_pass(Frame& F, const float* xl, const float* xc, int nrows, const float* gain, const float* mod  , int shoff) {
    bf16_t* H = (bf16_t*)(F.ws + WS_ACT);
    const int gw = F.vcu * 8 + F.wave, NGW = F.G * 8;
    f32x4 nx[2][4];
#define NP_LOAD(q, row_) do { const int r_ = (row_); if (r_ < nrows) { const float* xr_ = r_ < NL ? xl + (size_t)r_ * D : xc + (size_t)(r_ - NL) * D; \
        _Pragma("unroll") for (int j = 0; j < 4; ++j) nx[q][j] = *(const f32x4*)(xr_ + 512 * (j >> 1) + 8 * F.lane + 4 * (j & 1)); } } while (0)
    NP_LOAD(0, gw); NP_LOAD(1, gw + NGW);
    for (int row0 = gw; row0 < nrows; row0 += 2 * NGW) {
        f32x4 v[2][4];
#pragma unroll
        for (int q = 0; q < 2; ++q)
#pragma unroll
            for (int j = 0; j < 4; ++j) v[q][j] = nx[q][j];
        NP_LOAD(0, row0 + 2 * NGW); NP_LOAD(1, row0 + 3 * NGW);
#pragma unroll
        for (int q = 0; q < 2; ++q) { const int row = row0 + q * NGW;
            if (row < nrows) {
                const float* mrow = mod + (size_t)(row < NL ? (row >> 11) : 16) * 6144 + shoff;
                float s = 0.f;
#pragma unroll
                for (int j = 0; j < 4; ++j) s += (v[q][j].x * v[q][j].x + v[q][j].y * v[q][j].y) + (v[q][j].z * v[q][j].z + v[q][j].w * v[q][j].w);
                const float r = rsqrtf(wave_sum(s) * (1.f / D) + 1e-6f);
                f32x4 o[4];
#pragma unroll
                for (int j = 0; j < 4; ++j) { const int c = 512 * (j >> 1) + 8 * F.lane + 4 * (j & 1);
                    const f32x4 g = *(const f32x4*)(gain + c), sh = *(const f32x4*)(mrow + c), sc = *(const f32x4*)(mrow + 1024 + c);
                    o[j] = v[q][j] * r * g * (sc + 1.f) + sh; }
                *(u32x4*)(H + (size_t)row * D + 8 * F.lane) = pack8(o[0], o[1]);
                *(u32x4*)(H + (size_t)row * D + 512 + 8 * F.lane) = pack8(o[2], o[3]);
            } }
    }
#undef NP_LOAD
}
__device__ __forceinline__ void bias_pass(Frame& F, int widx, int nw, int m0, int nm) {
    const int mi = widx % nm, mat = m0 + mi, grp = widx / nm, ngrp = (nw - mi + nm - 1) / nm;
    const float* src = (const float*)(F.ws + WS_MOD) + (mat == 0 ? 0 : 17 * 6144) + (mat == 1 ? 0 : 3072);
    const bf16_t* WT = (const bf16_t*)(F.ws + (mat == 0 ? WS_WUP0 : (mat == 1 ? WS_WIN1 : WS_WUP1)));
    float* out = (float*)(F.ws + WS_BIAS + (mat == 0 ? BIAS_BU0 : (mat == 1 ? BIAS_BI1 : BIAS_BU1)));
    const int N = mat == 1 ? 2048 : 5632;
    LAS bf16_t* tb = (LAS bf16_t*)F.lds;
    __syncthreads();
    for (int e = F.tid; e < 32 * 512; e += 512) { const int r = e >> 9, kp = (e & 511) * 2;
        const float v0 = r < 17 ? src[(size_t)r * 6144 + kp] : 0.f, v1 = r < 17 ? src[(size_t)r * 6144 + kp + 1] : 0.f;
        *(LAS unsigned*)(tb + r * 1032 + kp) = cvt_pk_bf16(v0, v1); }
    __syncthreads();
    const int r32 = F.lane & 31, hi = F.lane >> 5;
    for (int blk = grp * 8 + F.wave; blk < N / 32; blk += ngrp * 8) {
        f32x16 acc;
#pragma unroll
        for (int r = 0; r < 16; ++r) acc[r] = 0.f;
        const bf16_t* ap = WT + (size_t)(blk * 32 + r32) * 1024 + hi * 8;
        const LAS bf16_t* bp = tb + r32 * 1032 + hi * 8;
#pragma unroll 16
        for (int s = 0; s < 64; ++s) acc = __builtin_amdgcn_mfma_f32_32x32x16_bf16(*(const bf16x8*)(ap + 16 * s), *(const LAS bf16x8*)(bp + 16 * s), acc, 0, 0, 0);
        if (r32 < 17) {
#pragma unroll
            for (int r = 0; r < 16; ++r) out[(size_t)r32 * N + blk * 32 + crow(r, hi)] = acc[r];
        }
    }
    __syncthreads();
}
__device__ __forceinline__ void rstd_table(const float* SS, int tok0, int ntok, LAS float* tab, int tid) {
    if (tid < 256) { const int tok = tok0 + tid; float r = 0.f;
        if (tok >= 0 && tok < ntok) { float t[16];
#pragma unroll
            for (int s = 0; s < 16; ++s) t[s] = SS[(size_t)s * NTOK + tok];
            r = rsqrtf((((t[0] + t[1]) + (t[2] + t[3])) + ((t[4] + t[5]) + (t[6] + t[7])) + (((t[8] + t[9]) + (t[10] + t[11])) + ((t[12] + t[13]) + (t[14] + t[15])))) * (1.f / 1024.f) + 1e-6f); }
        tab[tid] = r; }
}
typedef f32x4 Acc[2][2][4][2];
__device__ __forceinline__ u32x2 pack4(const f32x4 a) { u32x2 w; w.x = cvt_pk_bf16(a[0], a[1]); w.y = cvt_pk_bf16(a[2], a[3]); return w; }

__device__ __forceinline__ void rope_to_lds(Frame& F, LAS float* dst) { ((LAS f32x4*)dst)[F.tid] = ((const f32x4*)(F.ws + WS_ROPE))[F.tid]; }
struct EpiIn0 {
    static constexpr bool PF = false;
    unsigned char* ws; const float* qg; const float* kg; const LAS float* ropeL;
    __device__ __forceinline__ void operator()(Acc& acc, const pg8::Unit& u, int wr, int wc, int fr_, int fq_) const {
        int fr = fr_, fq = fq_; asm volatile("" : "+v"(fr), "+v"(fq));
        const int row0 = u.pm * 256 + wr * 64 + fr, pn = u.pn;
        if (pn < 2 || pn >= 10) {
            bf16_t* O = (bf16_t*)(ws + (pn < 2 ? WS_BG : WS_V)); const int colt = (pn < 2 ? pn : pn - 10) * 256 + wc * 32 + 8 * fq;
#pragma unroll
            for (int ai = 0; ai < 2; ++ai)
#pragma unroll
                for (int m = 0; m < 4; ++m)
#pragma unroll
                    for (int bj = 0; bj < 2; ++bj) *(u32x4*)(O + (size_t)(row0 + ai * 128 + m * 16) * 512 + colt + bj * 128) = pack8(acc[ai][bj][m][0], acc[ai][bj][m][1]);
        } else if (pn < 6) {
            bf16_t* O = (bf16_t*)(ws + WS_U); const int colt = (pn - 2) * 128 + wc * 32 + 8 * fq;
#pragma unroll
            for (int ai = 0; ai < 2; ++ai)
#pragma unroll
                for (int m = 0; m < 4; ++m) *(u32x4*)(O + (size_t)(row0 + ai * 128 + m * 16) * 512 + colt) = pack8(acc[ai][0][m][0] * acc[ai][1][m][0], acc[ai][0][m][1] * acc[ai][1][m][1]);
        } else {
            const int ch = (pn - 6) * 4 + wc; const bool isk = ch >= 8;
            bf16_t* O = (bf16_t*)(ws + (isk ? WS_K : WS_Q)) + 64 * (ch & 7);
            const float* gp = isk ? kg : qg; const float gs = isk ? 1.f : 0.125f * 1.4426950408889634f;
            const int ax = fq >> 1, dq = 32 * ax + 8 * (fq & 1);
            f32x4 gv[2][2];
#pragma unroll
            for (int bj = 0; bj < 2; ++bj)
#pragma unroll
                for (int n = 0; n < 2; ++n) gv[bj][n] = *(const f32x4*)(gp + dq + 16 * bj + 4 * n) * gs;
            const LAS float* ct = ropeL;
#pragma unroll
            for (int ai = 0; ai < 2; ++ai)
#pragma unroll
                for (int m = 0; m < 4; ++m) {
                    const int row = row0 + ai * 128 + m * 16;
                    float ss = 0.f;
#pragma unroll
                    for (int bj = 0; bj < 2; ++bj)
#pragma unroll
                        for (int n = 0; n < 2; ++n) { const f32x4 x = acc[ai][bj][m][n]; ss += (x[0] * x[0] + x[1] * x[1]) + (x[2] * x[2] + x[3] * x[3]); }
                    ss += __shfl_xor(ss, 16); ss += __shfl_xor(ss, 32);
                    const float ri = rsqrtf(ss * (1.f / 64.f) + 1e-6f);
                    const bool rot = row < NL; const int pos = row & 2047; const int idx = ax ? (pos & 63) : (pos >> 6);
                    f32x4 y1[2], y2[2];
#pragma unroll
                    for (int n = 0; n < 2; ++n) {
                        f32x4 x1 = acc[ai][0][m][n] * ri * gv[0][n], x2 = acc[ai][1][m][n] * ri * gv[1][n];
                        if (rot) { const f32x4 cs = *(const LAS f32x4*)(ct + idx * 16 + 8 * (fq & 1) + 4 * n), sn = *(const LAS f32x4*)(ct + 1024 + idx * 16 + 8 * (fq & 1) + 4 * n);
                            const f32x4 o1 = x1 * cs - x2 * sn, o2 = x1 * sn + x2 * cs; x1 = o1; x2 = o2; }
                        y1[n] = x1; y2[n] = x2;
                    }
                    *(u32x4*)(O + (size_t)row * 512 + dq) = pack8(y1[0], y1[1]);
                    *(u32x4*)(O + (size_t)row * 512 + dq + 16) = pack8(y2[0], y2[1]);
                }
        }
    }
};
struct EpiRes {
    static constexpr bool PF = false;
    __device__ __forceinline__ const char* pf_base(const pg8::Unit& u) const { const int trow = u.pm * 256; return (const char*)((trow < NL ? xin_l + (size_t)trow * D : xin_c + (size_t)(trow - NL) * D) + u.pn * 256); }
    const float* xin_l; const float* xin_c; float* xout_l; float* xout_c; const float* mod; int goff;
    bf16_t* An; const float* ngain; const float* nmod; int scoff; float* SS;
    __device__ __forceinline__ void operator()(Acc& acc, const pg8::Unit& u, int wr, int wc, int fr_, int fq_) const {
        int fr = fr_, fq = fq_; asm volatile("" : "+v"(fr), "+v"(fq));
        const int trow = u.pm * 256; const bool lat = trow < NL; const int brow = lat ? (trow >> 11) : 16;
        const float* xin = lat ? xin_l + (size_t)trow * D : xin_c + (size_t)(trow - NL) * D;
        float* xout = lat ? xout_l + (size_t)trow * D : xout_c + (size_t)(trow - NL) * D;
        const float* gp = mod + (size_t)brow * 6144 + goff;
        const int col0 = u.pn * 256 + wc * 32 + 8 * fq;
        f32x4 gv[2][2], gs[2][2];
#pragma unroll
        for (int bj = 0; bj < 2; ++bj)
#pragma unroll
            for (int n = 0; n < 2; ++n) { gv[bj][n] = *(const f32x4*)(gp + col0 + bj * 128 + n * 4);
                if (An) gs[bj][n] = *(const f32x4*)(ngain + col0 + bj * 128 + n * 4) * (*(const f32x4*)(nmod + (size_t)brow * 6144 + scoff + col0 + bj * 128 + n * 4) + 1.f); }
#pragma unroll
        for (int ai = 0; ai < 2; ++ai)
#pragma unroll
            for (int m = 0; m < 4; ++m) { const size_t off = (size_t)(ai * 128 + wr * 64 + m * 16 + fr) * D + col0;
#pragma unroll
                for (int bj = 0; bj < 2; ++bj)
#pragma unroll
                    for (int n = 0; n < 2; ++n) { const f32x4 xi = *(const f32x4*)(xin + off + bj * 128 + n * 4); acc[ai][bj][m][n] = xi + gv[bj][n] * acc[ai][bj][m][n]; }
                if (m == 3) { asm volatile("" : "+v"(acc[ai][0][0][0]), "+v"(acc[ai][0][0][1]), "+v"(acc[ai][1][0][0]), "+v"(acc[ai][1][0][1]), "+v"(acc[ai][0][1][0]), "+v"(acc[ai][0][1][1]), "+v"(acc[ai][1][1][0]), "+v"(acc[ai][1][1][1]), "+v"(acc[ai][0][2][0]), "+v"(acc[ai][0][2][1]), "+v"(acc[ai][1][2][0]), "+v"(acc[ai][1][2][1]), "+v"(acc[ai][0][3][0]), "+v"(acc[ai][0][3][1]), "+v"(acc[ai][1][3][0]), "+v"(acc[ai][1][3][1]) :: "memory"); } }
#pragma unroll
        for (int ai = 0; ai < 2; ++ai)
        { float ssr[4] = {0.f, 0.f, 0.f, 0.f};
#pragma unroll
            for (int m = 0; m < 4; ++m) { const int rl = ai * 128 + wr * 64 + m * 16 + fr; const size_t off = (size_t)rl * D + col0;
                float ss = 0.f;
#pragma unroll
                for (int bj = 0; bj < 2; ++bj)
                { const f32x4 x0 = acc[ai][bj][m][0], x1 = acc[ai][bj][m][1]; *(f32x4*)(xout + off + bj * 128) = x0; *(f32x4*)(xout + off + bj * 128 + 4) = x1;
                  if (An) { ss += ((x0[0] * x0[0] + x0[1] * x0[1]) + (x0[2] * x0[2] + x0[3] * x0[3])) + ((x1[0] * x1[0] + x1[1] * x1[1]) + (x1[2] * x1[2] + x1[3] * x1[3]));
                            *(u32x4*)(An + (size_t)(trow + rl) * D + col0 + bj * 128) = pack8(x0 * gs[bj][0], x1 * gs[bj][1]); } }
                if (An) { ss += __shfl_xor(ss, 16); ss += __shfl_xor(ss, 32); ssr[m] = ss; } }
            if (An) { const float sel = fq == 0 ? ssr[0] : fq == 1 ? ssr[1] : fq == 2 ? ssr[2] : ssr[3];
                SS[(size_t)(u.pn * 4 + wc) * NTOK + trow + ai * 128 + wr * 64 + 16 * fq + fr] = sel; } }
    }
};
template <int CTRL> __device__ __forceinline__ float dpp_mov(float old, float src) { return __int_as_float(__builtin_amdgcn_update_dpp(__float_as_int(old), __float_as_int(src), CTRL, 0xf, 0xf, false)); }
struct EpiUp {
    static constexpr bool PF = false;
    bf16_t* HACT; const float* cw; const float* cb; int ntok; LAS float* edge;
    const float* SS; const float* bias;
    int tokbase, tokmin;
    __device__ __forceinline__ void operator()(Acc& acc, const pg8::Unit& u, int wr, int wc, int fr_, int fq_) const {
        int fr = fr_, fq = fq_; asm volatile("" : "+v"(fr), "+v"(fq));
        const int tok0 = tokbase + u.pm * 254 - 1;
        LAS float* tab = edge + 1024;
        const int tlo = tok0 < 0 ? 0 : tok0, thi = tok0 + 255 >= ntok ? ntok - 1 : tok0 + 255;
        const int blo = tlo < NL ? (tlo >> 11) : 16, bhi = thi < NL ? (thi >> 11) : 16;
        const int split = (blo + 1) * 2048;
        const int colh = u.pn * 128 + wc * 32 + 8 * fq;
        f32x4 blv[2][2];
#pragma unroll
        for (int bj = 0; bj < 2; ++bj)
#pragma unroll
            for (int n = 0; n < 2; ++n) blv[bj][n] = *(const f32x4*)(bias + (size_t)blo * 5632 + u.pn * 256 + bj * 128 + wc * 32 + 16 * n + 4 * fq);
        f32x4 cwa[4];
        cwa[0] = *(const f32x4*)(cw + colh); cwa[1] = *(const f32x4*)(cw + FF + colh); cwa[2] = *(const f32x4*)(cw + 2 * FF + colh); cwa[3] = *(const f32x4*)(cb + colh);
        rstd_table(SS, tok0, ntok, tab, (wr * 4 + wc) * 64 + fq * 16 + fr);
        asm volatile("s_waitcnt lgkmcnt(0)" ::: "memory"); __builtin_amdgcn_s_barrier(); asm volatile("" ::: "memory");
        {
            float rs8[2][4];
#pragma unroll
            for (int ai = 0; ai < 2; ++ai)
#pragma unroll
                for (int m = 0; m < 4; ++m) rs8[ai][m] = tab[128 * ai + 64 * wr + 16 * m + fr];
#pragma unroll
            for (int bj = 0; bj < 2; ++bj)
#pragma unroll
                for (int n = 0; n < 2; ++n) {
                    const int tcol = u.pn * 256 + bj * 128 + wc * 32 + 16 * n + 4 * fq;
                    const f32x4 bl = blv[bj][n]; f32x4 bh = bl;
                    if (blo != bhi) bh = *(const f32x4*)(bias + (size_t)bhi * 5632 + tcol);
#pragma unroll
                    for (int ai = 0; ai < 2; ++ai)
#pragma unroll
                        for (int m = 0; m < 4; ++m) { const int r = 128 * ai + 64 * wr + 16 * m + fr; f32x4 bsel = bl; if (blo != bhi) bsel = (tok0 + r) >= split ? bh : bl;
                            acc[ai][bj][m][n] = acc[ai][bj][m][n] * rs8[ai][m] + bsel; }
                }
        }
#pragma unroll
        for (int ai = 0; ai < 2; ++ai) {
            if (fr == 0) { *(f32x4*)(edge + (((wr * 4 + wc) * 2 + ai) * 2 + 0) * 32 + 8 * fq) = acc[ai][0][0][0]; *(f32x4*)(edge + (((wr * 4 + wc) * 2 + ai) * 2 + 0) * 32 + 8 * fq + 4) = acc[ai][0][0][1]; }
            if (fr == 15) { *(f32x4*)(edge + (((wr * 4 + wc) * 2 + ai) * 2 + 1) * 32 + 8 * fq) = acc[ai][0][3][0]; *(f32x4*)(edge + (((wr * 4 + wc) * 2 + ai) * 2 + 1) * 32 + 8 * fq + 4) = acc[ai][0][3][1]; }
        }
        asm volatile("s_waitcnt lgkmcnt(0)" ::: "memory"); __builtin_amdgcn_s_barrier(); asm volatile("" ::: "memory");
        const int lo_ = tok0 < 1 ? 1 : tok0;
        const bool anyb = (tok0 + 256 >= NL) || (tok0 < 1) || (((lo_ - 1) >> 11) != ((tok0 + 256) >> 11));
        u32x2 stash[2][4];
#pragma unroll
        for (int n = 0; n < 2; ++n) {
            const f32x4 w0 = n == 0 ? cwa[0] : *(const f32x4*)(cw + colh + 4), w1 = n == 0 ? cwa[1] : *(const f32x4*)(cw + FF + colh + 4), w2 = n == 0 ? cwa[2] : *(const f32x4*)(cw + 2 * FF + colh + 4),
                        bb = n == 0 ? cwa[3] : *(const f32x4*)(cb + colh + 4);
#pragma unroll
            for (int ai = 0; ai < 2; ++ai) {
                const int seg = 2 * ai + wr;
                const int ps = seg > 0 ? seg - 1 : 0, ns = seg < 3 ? seg + 1 : 3;
                const f32x4 pe = *(const LAS f32x4*)(edge + ((((ps & 1) * 4 + wc) * 2 + (ps >> 1)) * 2 + 1) * 32 + 8 * fq + 4 * n);
                const f32x4 ne = *(const LAS f32x4*)(edge + ((((ns & 1) * 4 + wc) * 2 + (ns >> 1)) * 2 + 0) * 32 + 8 * fq + 4 * n);
#pragma unroll
                for (int m = 0; m < 4; ++m) {
                    const int r = 64 * seg + 16 * m + fr, tok = tok0 + r;
                    const bool first = tok < NL ? (tok & 2047) == 0 : (tok & 255) == 0;
                    const int tn = tok + 1; const bool last = (tn >= ntok) || (tn < NL ? (tn & 2047) == 0 : (tn & 255) == 0);
                    f32x4 pv, nv;
#pragma unroll
                    for (int j = 0; j < 4; ++j) {
                        const float cur = acc[ai][0][m][n][j];
                        const float pold = m > 0 ? dpp_mov<0x121>(0.f, acc[ai][0][m > 0 ? m - 1 : 0][n][j]) : pe[j];
                        const float nold = m < 3 ? dpp_mov<0x12F>(0.f, acc[ai][0][m < 3 ? m + 1 : 3][n][j]) : ne[j];
                        pv[j] = dpp_mov<0x111>(pold, cur);
                        nv[j] = dpp_mov<0x101>(nold, cur);
                    }
                    if (anyb) { if (first) pv = (f32x4){0.f, 0.f, 0.f, 0.f}; if (last) nv = (f32x4){0.f, 0.f, 0.f, 0.f}; }
                    const f32x4 a = pv * w0 + acc[ai][0][m][n] * w1 + nv * w2 + bb;
                    f32x4 hv;
#pragma unroll
                    for (int j = 0; j < 4; ++j) hv[j] = fast_silu(a[j]) * acc[ai][1][m][n][j];
                    if (n == 0) stash[ai][m] = pack4(hv);
                    else { const u32x2 hi2 = pack4(hv); const u32x4 w = {stash[ai][m].x, stash[ai][m].y, hi2.x, hi2.y};
                           if (r >= 1 && r <= 254 && tok < ntok && tok >= tokmin) *(u32x4*)(HACT + (size_t)tok * FF + colh) = w; }
                }
            }
        }
    }
};
struct EpiIn1 {
    static constexpr bool PF = false;
    unsigned char* ws; const float* decf; const float* decb; const float* SS; const float* bias; LAS float* tab;
    __device__ __forceinline__ void operator()(Acc& acc, const pg8::Unit& u, int wr, int wc, int fr_, int fq_) const {
        int fr = fr_, fq = fq_; asm volatile("" : "+v"(fr), "+v"(fq));
        const int row0 = u.pm * 256 + wr * 64 + fr, pn = u.pn;
        {
            const float* bp = bias + (size_t)(u.pm < 128 ? (u.pm >> 3) : 16) * 2048 + pn * 256 + wc * 32 + 4 * fq;
            f32x4 bvv[2][2];
#pragma unroll
            for (int bj = 0; bj < 2; ++bj)
#pragma unroll
                for (int n = 0; n < 2; ++n) bvv[bj][n] = *(const f32x4*)(bp + bj * 128 + n * 16);
            rstd_table(SS, u.pm * 256, NTOK, tab, (wr * 4 + wc) * 64 + fq * 16 + fr);
            asm volatile("s_waitcnt lgkmcnt(0)" ::: "memory"); __builtin_amdgcn_s_barrier(); asm volatile("" ::: "memory");
#pragma unroll
            for (int bj = 0; bj < 2; ++bj)
#pragma unroll
                for (int n = 0; n < 2; ++n) { const f32x4 bv = bvv[bj][n];
#pragma unroll
                    for (int ai = 0; ai < 2; ++ai)
#pragma unroll
                        for (int m = 0; m < 4; ++m) acc[ai][bj][m][n] = acc[ai][bj][m][n] * tab[ai * 128 + wr * 64 + m * 16 + fr] + bv; }
            asm volatile("s_waitcnt lgkmcnt(0)" ::: "memory"); __builtin_amdgcn_s_barrier(); asm volatile("" ::: "memory");
        }
        if (pn == 2 || pn == 3) {
            const bool isk = pn == 3; const int h = wc;
            const float lf2 = -__expf(decf[h]) * 1.4426950408889634f, lb2 = -__expf(decb[h]) * 1.4426950408889634f;
            const size_t hb = (size_t)h * (isk ? NTOK : NL) * 64;
            bf16_t* OF = (bf16_t*)(ws + (isk ? WS_KF : WS_QF)) + hb; bf16_t* OB = (bf16_t*)(ws + (isk ? WS_KB : WS_QB)) + hb;
            const LAS float* ct = tab + 256;
#pragma unroll
            for (int ai = 0; ai < 2; ++ai)
#pragma unroll
                for (int m = 0; m < 4; ++m) {
                    const int row = row0 + ai * 128 + m * 16; const bool rot = row < NL; const int pos = row & 2047; const float p = (float)(row & 127);
                    const float sf = isk ? __builtin_amdgcn_exp2f(-lf2 * p) : 0.125f * __builtin_amdgcn_exp2f(lf2 * p);
                    const float sb = isk ? __builtin_amdgcn_exp2f(lb2 * (p - 127.f)) : 0.125f * __builtin_amdgcn_exp2f(lb2 * (127.f - p));
                    const int ax = fq >> 1, dq = 32 * ax + 8 * (fq & 1), idx = ax ? (pos & 63) : (pos >> 6);
                    f32x4 y1[2], y2[2];
#pragma unroll
                    for (int n = 0; n < 2; ++n) {
                        f32x4 x1 = acc[ai][0][m][n], x2 = acc[ai][1][m][n];
                        if (rot) { const f32x4 cs = *(const LAS f32x4*)(ct + idx * 16 + 8 * (fq & 1) + 4 * n), sn = *(const LAS f32x4*)(ct + 1024 + idx * 16 + 8 * (fq & 1) + 4 * n);
                            const f32x4 o1 = x1 * cs - x2 * sn, o2 = x1 * sn + x2 * cs; x1 = o1; x2 = o2; }
                        y1[n] = x1; y2[n] = x2;
                    }
                    *(u32x4*)(OF + (size_t)row * 64 + dq) = pack8(y1[0] * sf, y1[1] * sf); *(u32x4*)(OF + (size_t)row * 64 + dq + 16) = pack8(y2[0] * sf, y2[1] * sf);
                    *(u32x4*)(OB + (size_t)row * 64 + dq) = pack8(y1[0] * sb, y1[1] * sb); *(u32x4*)(OB + (size_t)row * 64 + dq + 16) = pack8(y2[0] * sb, y2[1] * sb);
                }
        } else {
            const bool isg = pn >= 6;
            if (pn < 2) {
                bf16_t* O = (bf16_t*)(ws + WS_PV); const int colt = pn * 256 + wc * 32 + 8 * fq;
#pragma unroll
                for (int ai = 0; ai < 2; ++ai)
#pragma unroll
                    for (int m = 0; m < 4; ++m)
#pragma unroll
                        for (int bj = 0; bj < 2; ++bj) *(u32x4*)(O + (size_t)(row0 + ai * 128 + m * 16) * 512 + colt + bj * 128) = pack8(acc[ai][bj][m][0], acc[ai][bj][m][1]);
            } else {
                bf16_t* O = (bf16_t*)(ws + (isg ? WS_G1 : WS_V1)); const size_t nr = isg ? NL : NTOK; const int hp = 2 * (pn - (isg ? 6 : 4));
#pragma unroll
                for (int ai = 0; ai < 2; ++ai)
#pragma unroll
                    for (int m = 0; m < 4; ++m)
#pragma unroll
                        for (int bj = 0; bj < 2; ++bj) { f32x4 a = acc[ai][bj][m][0], b = acc[ai][bj][m][1];
                            if (isg) {
#pragma unroll
                                for (int j = 0; j < 4; ++j) { a[j] = fast_silu(a[j]); b[j] = fast_silu(b[j]); } }
                            *(u32x4*)(O + ((size_t)(hp + bj) * nr + row0 + ai * 128 + m * 16) * 128 + wc * 32 + 8 * fq) = pack8(a, b); }
            }
        }
    }
};
struct OrderIn1 {
    pg8::StaticOrder so; int G, c;
    __device__ void init(int G_, int c_) { so.init(128, 8, G_, c_); G = G_; c = c_; }
    __device__ bool next(int i, pg8::Unit& u) const {
        const int L = i * G + c;
        if (L < 1024) return so.next(i, u);
        const int e = L - 1024; if (e >= 48) return false;
        u.pm = 128 + e / 3; u.pn = 3 + e % 3; return true;
    }
};
}
namespace mk {
#define MFMA32(a, b, c) __builtin_amdgcn_mfma_f32_32x32x16_bf16((a), (b), (c), 0, 0, 0)
__device__ __forceinline__ bf16x8 as_bf16x8(u32x4 v) { return __builtin_bit_cast(bf16x8, v); }

struct AttnCtx { const bf16_t* Q; const bf16_t* K; const bf16_t* V; bf16_t* A2; const float* subln; float lam, negMb; };
__device__ __forceinline__ void attn_unit(Frame& F, const AttnCtx& C, int h, int qrow0, int ka, int nta, int kb, int ntb) {
    const int lane = F.lane, w = F.wave, r32 = lane & 31, hi = lane >> 5, mp = w >> 2, qb = w & 3;
    const unsigned lds0 = (unsigned)(uintptr_t)F.lds;
    const LAS char* L = (const LAS char*)F.lds;
    LAS float* wsf = (LAS float*)(F.lds + 114688 + 256 * w);
    const bf16_t* qp = C.Q + (size_t)(qrow0 + 32 * qb + r32) * 512 + h * 128 + mp * 64 + hi * 8;
    bf16x8 qr[4];
#pragma unroll
    for (int d0 = 0; d0 < 4; ++d0) qr[d0] = *(const bf16x8*)(qp + d0 * 16);
    const bf16_t* ksrc = C.K + (size_t)lane * 512 + h * 128 + w * 8;
    const int pv0 = 2 * w, pv1 = 2 * w + 1;
    const bf16_t* vsrc0 = C.V + (size_t)(16 * (pv0 & 3) + (lane >> 2)) * 512 + h * 128 + (pv0 >> 2) * 32 + (lane & 3) * 8;
    const bf16_t* vsrc1 = C.V + (size_t)(16 * (pv1 & 3) + (lane >> 2)) * 512 + h * 128 + (pv1 >> 2) * 32 + (lane & 3) * 8;
    const int NT = nta + ntb;
#define AT_ROW(t_) ((size_t)((t_) < nta ? ka + 64 * (t_) : kb + 64 * ((t_) - nta)) * 512)
#define AT_ISSUE_K(t, slot) do { const size_t ko_ = AT_ROW(t); const unsigned sb_ = lds0 + (unsigned)(slot) * 16384u; \
        glds16(ksrc + ko_, (unsigned)__builtin_amdgcn_readfirstlane(sb_ + w * 1024)); glds16(ksrc + ko_ + 64, (unsigned)__builtin_amdgcn_readfirstlane(sb_ + 8192 + w * 1024)); } while (0)
#define AT_ISSUE_V(t, slot) do { const size_t ko_ = AT_ROW(t); const unsigned sb_ = lds0 + 65536u + (unsigned)(slot) * 16384u; \
        glds16(vsrc0 + ko_, (unsigned)__builtin_amdgcn_readfirstlane(sb_ + pv0 * 1024)); glds16(vsrc1 + ko_, (unsigned)__builtin_amdgcn_readfirstlane(sb_ + pv1 * 1024)); } while (0)
#define SBAR() __builtin_amdgcn_sched_barrier(0)
    AT_ISSUE_K(0, 0); AT_ISSUE_K(1, 1); if (2 < NT) AT_ISSUE_K(2, 2); AT_ISSUE_V(0, 0);
    f32x16 o[4];
#pragma unroll
    for (int d0 = 0; d0 < 4; ++d0)
#pragma unroll
        for (int r = 0; r < 16; ++r) o[d0][r] = 0.f;
    float lsum = 0.f;
    f32x16 e0, e1;
    const LAS char* kb0 = L + mp * 8192 + hi * 1024 + r32 * 16;
    const LAS char* vb0 = L + 65536 + ((lane >> 4) & 1) * 32 + (lane & 3) * 8 + (4 * hi + ((lane & 15) >> 2)) * 64;
    WAIT_BAR(4);
    if (3 < NT) AT_ISSUE_K(3, 3);
    if (1 < NT) AT_ISSUE_V(1, 1);
    bf16x8 kf[8];
    {
#pragma unroll
        for (int r = 0; r < 16; ++r) { e0[r] = 0.f; e1[r] = 0.f; }
#pragma unroll
        for (int d0 = 0; d0 < 4; ++d0) { e0 = MFMA32(*(const LAS bf16x8*)(kb0 + d0 * 2048), qr[d0], e0); e1 = MFMA32(*(const LAS bf16x8*)(kb0 + d0 * 2048 + 512), qr[d0], e1); }
#pragma unroll
        for (int d0 = 0; d0 < 4; ++d0) { kf[2 * d0] = *(const LAS bf16x8*)(kb0 + 16384 + d0 * 2048); kf[2 * d0 + 1] = *(const LAS bf16x8*)(kb0 + 16384 + d0 * 2048 + 512); }
#pragma unroll
        for (int r = 0; r < 16; ++r) { e0[r] = __builtin_amdgcn_exp2f(e0[r]); e1[r] = __builtin_amdgcn_exp2f(e1[r]); }
    }
    int ks_ = 1, vs_ = 0;
    for (int t = 1; t < NT; ++t) {
        if (t + 2 < NT) { WAIT_BAR(4); } else { WAIT_BAR(2); }
        { int kn = (ks_ + 3) & 3; int vn = vs_ + 2; if (vn >= 3) vn -= 3;
          if (t + 3 < NT) AT_ISSUE_K(t + 3, kn);
          if (t + 1 < NT) AT_ISSUE_V(t + 1, vn); }
        const int kn1 = (ks_ + 1) & 3;
        const LAS char* kbn = kb0 + kn1 * 16384;
        const LAS char* vbp = vb0 + vs_ * 16384;
        const bool more = t + 1 < NT;
        f32x16 n0, n1;
#pragma unroll
        for (int r = 0; r < 16; ++r) { n0[r] = 0.f; n1[r] = 0.f; }
        u32x4 pw[4];
#define AT_VOFF(J) ((((J) & 3) * 4096) + (((J) >> 2) * 1024))
        s16x4 vl0 = tr_read(vbp + AT_VOFF(0)), vh0 = tr_read(vbp + AT_VOFF(0) + 512);
        s16x4 vl1 = tr_read(vbp + AT_VOFF(1)), vh1 = tr_read(vbp + AT_VOFF(1) + 512);
        s16x4 vl2, vh2;
        SBAR();
#define AT_A(ACC, KF, QD, EV, EB, PWK, PWI) do { ACC = MFMA32(KF, qr[QD], ACC); \
        lsum += (EV[EB] + EV[EB + 1]) + (EV[EB + 2] + EV[EB + 3]); pw[PWK][PWI] = cvt_pk_bf16(EV[EB], EV[EB + 1]); pw[PWK][PWI + 1] = cvt_pk_bf16(EV[EB + 2], EV[EB + 3]); SBAR(); } while (0)
        AT_A(n0, kf[0], 0, e0, 0, 0, 0);  AT_A(n1, kf[1], 0, e0, 4, 0, 2);
        AT_A(n0, kf[2], 1, e0, 8, 1, 0);  AT_A(n1, kf[3], 1, e0, 12, 1, 2);
        AT_A(n0, kf[4], 2, e1, 0, 2, 0);  AT_A(n1, kf[5], 2, e1, 4, 2, 2);
        AT_A(n0, kf[6], 3, e1, 8, 3, 0);  AT_A(n1, kf[7], 3, e1, 12, 3, 2);
#undef AT_A
#define AT_B(J, CL, CH, NL_, NH_, NV, NB, KLOAD) do { if ((J) + 2 < 16) { NL_ = tr_read(vbp + AT_VOFF((J) + 2)); NH_ = tr_read(vbp + AT_VOFF((J) + 2) + 512); } KLOAD; \
        o[(J) & 3] = MFMA32(as_bf16x8(pw[(J) >> 2]), cat8(CL, CH), o[(J) & 3]); NV[NB] = __builtin_amdgcn_exp2f(NV[NB]); NV[NB + 1] = __builtin_amdgcn_exp2f(NV[NB + 1]); SBAR(); } while (0)
#define AT_KL(I) do { if (more) kf[I] = *(const LAS bf16x8*)(kbn + ((I) >> 1) * 2048 + ((I) & 1) * 512); } while (0)
        AT_B(0, vl0, vh0, vl2, vh2, n0, 0, (void)0);    AT_B(1, vl1, vh1, vl0, vh0, n0, 2, (void)0);    AT_B(2, vl2, vh2, vl1, vh1, n0, 4, (void)0);
        AT_B(3, vl0, vh0, vl2, vh2, n0, 6, (void)0);    AT_B(4, vl1, vh1, vl0, vh0, n0, 8, (void)0);    AT_B(5, vl2, vh2, vl1, vh1, n0, 10, (void)0);
        AT_B(6, vl0, vh0, vl2, vh2, n0, 12, (void)0);   AT_B(7, vl1, vh1, vl0, vh0, n0, 14, (void)0);   AT_B(8, vl2, vh2, vl1, vh1, n1, 0, AT_KL(0));
        AT_B(9, vl0, vh0, vl2, vh2, n1, 2, AT_KL(1));   AT_B(10, vl1, vh1, vl0, vh0, n1, 4, AT_KL(2));  AT_B(11, vl2, vh2, vl1, vh1, n1, 6, AT_KL(3));
        AT_B(12, vl0, vh0, vl2, vh2, n1, 8, AT_KL(4));  AT_B(13, vl1, vh1, vl0, vh0, n1, 10, AT_KL(5)); AT_B(14, vl2, vh2, vl1, vh1, n1, 12, AT_KL(6));
        AT_B(15, vl0, vh0, vl2, vh2, n1, 14, AT_KL(7));
#undef AT_B
#undef AT_KL
#undef AT_VOFF
        e0 = n0; e1 = n1;
        ks_ = (ks_ + 1) & 3;
        vs_ = vs_ + 1; if (vs_ >= 3) vs_ = 0;
    }
    WAIT_BAR(0);
    {
        const LAS char* vbp = vb0 + vs_ * 16384;
        u32x4 pw[4];
#pragma unroll
        for (int i = 0; i < 4; ++i) { pw[0][i] = cvt_pk_bf16(e0[2 * i], e0[2 * i + 1]); pw[1][i] = cvt_pk_bf16(e0[8 + 2 * i], e0[9 + 2 * i]); pw[2][i] = cvt_pk_bf16(e1[2 * i], e1[2 * i + 1]); pw[3][i] = cvt_pk_bf16(e1[8 + 2 * i], e1[9 + 2 * i]); }
#pragma unroll
        for (int r = 0; r < 16; ++r) lsum += e0[r] + e1[r];
#pragma unroll
        for (int d0 = 0; d0 < 4; ++d0)
#pragma unroll
            for (int ks = 0; ks < 4; ++ks) {
                const s16x4 lo = tr_read(vbp + d0 * 4096 + ks * 1024), hh = tr_read(vbp + d0 * 4096 + ks * 1024 + 512);
                o[d0] = MFMA32(as_bf16x8(pw[ks]), cat8(lo, hh), o[d0]);
            }
    }
#undef AT_ISSUE_K
#undef AT_ISSUE_V
#undef AT_ROW
#undef SBAR
    lsum += __shfl_xor(lsum, 32);
    if (hi == 0) wsf[r32] = (mp ? C.lam : 1.f) / lsum;
    asm volatile("s_waitcnt lgkmcnt(0)" ::: "memory");
    float rli[16];
#pragma unroll
    for (int r = 0; r < 16; ++r) rli[r] = wsf[crow(r, hi)];
    asm volatile("s_waitcnt lgkmcnt(0)" ::: "memory"); __builtin_amdgcn_s_barrier(); asm volatile("" ::: "memory");
    LAS float* CB = (LAS float*)F.lds;
    if (mp == 1) {
#pragma unroll
        for (int d0 = 0; d0 < 4; ++d0)
#pragma unroll
            for (int r = 0; r < 16; ++r) CB[(32 * qb + crow(r, hi)) * 132 + 32 * d0 + r32] = o[d0][r] * rli[r];
    }
    asm volatile("s_waitcnt lgkmcnt(0)" ::: "memory"); __builtin_amdgcn_s_barrier(); asm volatile("" ::: "memory");
    if (mp == 0) {
#pragma unroll
        for (int d0 = 0; d0 < 4; ++d0)
#pragma unroll
            for (int r = 0; r < 16; ++r) { LAS float* p = CB + (32 * qb + crow(r, hi)) * 132 + 32 * d0 + r32; *p = o[d0][r] * rli[r] - *p; }
        asm volatile("s_waitcnt lgkmcnt(0)" ::: "memory");
        const int row = lane >> 1, half = lane & 1;
        const LAS float* rp = CB + (32 * qb + row) * 132 + 64 * half;
        f32x4 v[16]; float ss = 0.f;
#pragma unroll
        for (int i = 0; i < 16; ++i) { v[i] = *(const LAS f32x4*)(rp + 4 * i); ss += (v[i][0] * v[i][0] + v[i][1] * v[i][1]) + (v[i][2] * v[i][2] + v[i][3] * v[i][3]); }
        ss += __shfl_xor(ss, 1);
        const float ri = rsqrtf(ss * (1.f / 128.f) + 1e-6f) * 0.8f;
        bf16_t* op = C.A2 + (size_t)(qrow0 + 32 * qb + row) * 1024 + 512 + h * 128 + 64 * half;
#pragma unroll
        for (int i = 0; i < 8; ++i) {
            const f32x4 g0 = *(const f32x4*)(C.subln + 64 * half + 8 * i), g1 = *(const f32x4*)(C.subln + 64 * half + 8 * i + 4);
            *(u32x4*)(op + 8 * i) = pack8(v[2 * i] * ri * g0, v[2 * i + 1] * ri * g1);
        }
    }
    asm volatile("s_waitcnt lgkmcnt(0)" ::: "memory"); __builtin_amdgcn_s_barrier(); asm volatile("" ::: "memory");
}
__device__ __forceinline__ void attn_phase(Frame& F) {
    AttnCtx C;
    C.Q = (const bf16_t*)(F.ws + WS_Q); C.K = (const bf16_t*)(F.ws + WS_K); C.V = (const bf16_t*)(F.ws + WS_V); C.A2 = (bf16_t*)(F.ws + WS_ACT); C.subln = F.in[17];
    {
        const float a1 = wave_sum(F.in[13][F.lane] * F.in[14][F.lane]), a2 = wave_sum(F.in[15][F.lane] * F.in[16][F.lane]);
        C.lam = __expf(a1) - __expf(a2) + 0.2f;
        const float mq = wave_max(fabsf(F.in[11][F.lane])), mkk = wave_max(fabsf(F.in[12][F.lane]));
        C.negMb = -(8.f * mq * mkk * 1.4426950408889634f * 1.01f + 0.1f);
    }
    for (int u = F.vcu; u < 1152; u += F.G) {
        if (u < 1024) { const int b = u >> 6, h = (u >> 4) & 3, qb = u & 15; attn_unit(F, C, h, b * 2048 + 128 * qb, b * 2048, 32, NL + b * 256, 4); }
        else { const int e = u - 1024, b = e >> 3, h = (e >> 1) & 3, qb = e & 1; attn_unit(F, C, h, NL + b * 256 + 128 * qb, NL + b * 256, 4, 0, 0); }
    }
}
__device__ __forceinline__ void convgate_pass(Frame& F, int part, int nparts) {
    const bf16_t* BG = (const bf16_t*)(F.ws + WS_BG); const bf16_t* U = (const bf16_t*)(F.ws + WS_U); bf16_t* A2 = (bf16_t*)(F.ws + WS_ACT); const float* cw = F.in[10];
    for (int it = part * 512 + F.tid; it < NTOK * 64; it += nparts * 512) {
        const int row = it >> 6, c = (it & 63) * 8;
        const bool first = row < NL ? (row & 2047) == 0 : (row & 255) == 0, last = row < NL ? (row & 2047) == 2047 : (row & 255) == 255;
        const u32x4 z = {0u, 0u, 0u, 0u};
        const u32x4 bg = *(const u32x4*)(BG + (size_t)row * 512 + c), u1 = *(const u32x4*)(U + (size_t)row * 512 + c);
        const u32x4 u0 = first ? z : *(const u32x4*)(U + (size_t)(row - 1) * 512 + c), u2 = last ? z : *(const u32x4*)(U + (size_t)(row + 1) * 512 + c);
        float o[8];
#pragma unroll
        for (int i = 0; i < 4; ++i) {
            const float w0a = cw[c + 2 * i], w0b = cw[c + 2 * i + 1], w1a = cw[512 + c + 2 * i], w1b = cw[512 + c + 2 * i + 1], w2a = cw[1024 + c + 2 * i], w2b = cw[1024 + c + 2 * i + 1];
            o[2 * i] = bf_lo(bg[i]) * (bf_lo(u0[i]) * w0a + bf_lo(u1[i]) * w1a + bf_lo(u2[i]) * w2a);
            o[2 * i + 1] = bf_hi(bg[i]) * (bf_hi(u0[i]) * w0b + bf_hi(u1[i]) * w1b + bf_hi(u2[i]) * w2b);
        }
        u32x4 w; w.x = cvt_pk_bf16(o[0], o[1]); w.y = cvt_pk_bf16(o[2], o[3]); w.z = cvt_pk_bf16(o[4], o[5]); w.w = cvt_pk_bf16(o[6], o[7]);
        *(u32x4*)(A2 + (size_t)row * 1024 + c) = w;
    }
}
__device__ __forceinline__ void pool_pass(Frame& F) {
    const bf16_t* PV = (const bf16_t*)(F.ws + WS_PV); bf16_t* A6 = (bf16_t*)(F.ws + WS_ACT);
    for (int it = F.vcu * 512 + F.tid; it < NL * 64; it += F.G * 512) {
        const int row = it >> 6, c = (it & 63) * 8, t = row & 2047, rad = 1 << (c >> 7);
        const int lo = max(t - rad, 0), hi = min(t + rad + 1, 2048);
        float s[8];
#pragma unroll
        for (int i = 0; i < 8; ++i) s[i] = 0.f;
        const bf16_t* base = PV + (size_t)(row - t) * 512 + c;
        for (int j = lo; j < hi; ++j) { const u32x4 v = *(const u32x4*)(base + (size_t)j * 512);
#pragma unroll
            for (int i = 0; i < 4; ++i) { s[2 * i] += bf_lo(v[i]); s[2 * i + 1] += bf_hi(v[i]); } }
        const float inv = 1.f / (float)(hi - lo);
        const u32x4 v = *(const u32x4*)(base + (size_t)t * 512);
        u32x4 w;
#pragma unroll
        for (int i = 0; i < 4; ++i) w[i] = cvt_pk_bf16(s[2 * i] * inv - bf_lo(v[i]), s[2 * i + 1] * inv - bf_hi(v[i]));
        *(u32x4*)(A6 + (size_t)row * 1024 + c) = w;
    }
}
__device__ __forceinline__ void dma_tile(const bf16_t* src, int ld, int nrows, int rowbytes, unsigned dst, int wi, int nw, int lane) {
    const int lpr = rowbytes >> 4, rpp = 64 / lpr, npieces = nrows / rpp;
    for (int p = wi; p < npieces; p += nw) {
        const int row = p * rpp + lane / lpr, ch = lane % lpr;
        glds16(src + (size_t)row * ld + ch * 8, (unsigned)__builtin_amdgcn_readfirstlane(dst + p * 1024));
    }
}
template <int ORD> __device__ __forceinline__ bf16x8 tr_frag(const LAS char* tile, int rs, int k0, int c0, int lane) {
    const int hi = lane >> 5, q = (lane & 15) >> 2;
    const int colb = (c0 + 16 * ((lane >> 4) & 1) + 4 * (lane & 3)) * 2;
    const int r0 = ORD ? k0 + 4 * hi + q : k0 + 8 * hi + q, r1 = ORD ? r0 + 8 : r0 + 4;
    return cat8(tr_read(tile + r0 * rs + colb), tr_read(tile + r1 * rs + colb));
}
__device__ __forceinline__ void ret_states_unit(Frame& F, int bh, int dir, int vh) {
    const int lane = F.lane, w = F.wave, hi = lane >> 5, r32 = lane & 31, mb = (w >> 1) & 1, nb = w & 1, b = bh >> 2, h = bh & 3;
    const bool comp = w < 4;
    const unsigned lds0 = (unsigned)(uintptr_t)F.lds; const LAS char* L = (const LAS char*)F.lds;
    const bf16_t* KP = (const bf16_t*)(F.ws + (dir ? WS_KB : WS_KF)); const bf16_t* V1 = (const bf16_t*)(F.ws + WS_V1); bf16_t* ST = (bf16_t*)(F.ws + WS_ST);
    const float lg = -__expf((dir ? F.in[23] : F.in[22])[h]) * 1.4426950408889634f, l128 = __builtin_amdgcn_exp2f(lg * 128.f);
#define RS_ROW0(i) ((i) < 2 ? NL + b * 256 + ((dir ? 1 - (i) : (i)) * 128) : b * 2048 + (dir ? 17 - (i) : (i) - 2) * 128)
#define RS_ISSUE(i, slot) do { const int r0_ = RS_ROW0(i); const unsigned sb_ = lds0 + (unsigned)(slot) * 32768u; \
        dma_tile(KP + ((size_t)h * NTOK + r0_) * 64, 64, 128, 128, sb_, w, 8, lane); dma_tile(V1 + ((size_t)h * NTOK + r0_) * 128 + vh * 64, 128, 128, 128, sb_ + 16384, w, 8, lane); } while (0)
    RS_ISSUE(0, 0); RS_ISSUE(1, 1);
    f32x16 acc;
#pragma unroll
    for (int r = 0; r < 16; ++r) acc[r] = 0.f;
    u32x2 held[4] = {{0u, 0u}, {0u, 0u}, {0u, 0u}, {0u, 0u}};
    int slot = 0;
    for (int i = 0; i < 18; ++i) {
        if (i < 17) { WAIT_BAR(4); } else { WAIT_BAR(0); }
        if (comp && i >= 2) {
            u32x2 pk[4];
#pragma unroll
            for (int g = 0; g < 4; ++g) { pk[g].x = cvt_pk_bf16(acc[4 * g] * l128, acc[4 * g + 1] * l128); pk[g].y = cvt_pk_bf16(acc[4 * g + 2] * l128, acc[4 * g + 3] * l128); }
            if (((i - 2) & 1) == 0) {
#pragma unroll
                for (int g = 0; g < 4; ++g) held[g] = pk[g];
            } else {
                const int c = dir ? 17 - i : i - 2, cp = dir ? c + 1 : c - 1;
                bf16_t* sp = ST + (((size_t)bh * 16 + c) * 2 + dir) * 8192 + (size_t)(64 * vh + 32 * nb + r32) * 64 + 32 * mb + 4 * hi;
                bf16_t* spp = ST + (((size_t)bh * 16 + cp) * 2 + dir) * 8192 + (size_t)(64 * vh + 32 * nb + r32) * 64 + 32 * mb + 4 * hi;
#pragma unroll
                for (int g = 0; g < 4; ++g) { *(u32x2*)(spp + 8 * g) = held[g]; *(u32x2*)(sp + 8 * g) = pk[g]; }
            }
        }
        int s2 = slot + 2; if (s2 >= 3) s2 -= 3;
        if (i + 2 < 18) RS_ISSUE(i + 2, s2);
        if (comp) {
#pragma unroll
            for (int r = 0; r < 16; ++r) acc[r] *= l128;
            if (i < 17) {
                const LAS char* kt = L + slot * 32768; const LAS char* vt = kt + 16384;
                f32x16 acc2;
#pragma unroll
                for (int r = 0; r < 16; ++r) acc2[r] = 0.f;
#pragma unroll
                for (int s = 0; s < 8; s += 2) {
                    acc = MFMA32(tr_frag<0>(kt, 128, 16 * s, 32 * mb, lane), tr_frag<0>(vt, 128, 16 * s, 32 * nb, lane), acc);
                    acc2 = MFMA32(tr_frag<0>(kt, 128, 16 * s + 16, 32 * mb, lane), tr_frag<0>(vt, 128, 16 * s + 16, 32 * nb, lane), acc2);
                }
#pragma unroll
                for (int r = 0; r < 16; ++r) acc[r] += acc2[r];
            }
        }
        slot = slot + 1; if (slot >= 3) slot = 0;
    }
#undef RS_ISSUE
#undef RS_ROW0
    asm volatile("s_waitcnt lgkmcnt(0)" ::: "memory"); __builtin_amdgcn_s_barrier(); asm volatile("" ::: "memory");
}
template <int R> __device__ __forceinline__ void pool_item(const bf16_t* PV, bf16_t* A6, int row0, int c) {
    const int t0 = row0 & 2047;
    const bf16_t* base = PV + (size_t)(row0 - t0) * 512 + c;
    u32x4 v[16 + 2 * R];
#pragma unroll
    for (int i = 0; i < 16 + 2 * R; ++i) { const int t = t0 - R + i; v[i] = (t >= 0 && t < 2048) ? *(const u32x4*)(base + (size_t)t * 512) : (u32x4){0u, 0u, 0u, 0u}; }
    float s[8];
#pragma unroll
    for (int k = 0; k < 8; ++k) s[k] = 0.f;
#pragma unroll
    for (int i = 0; i < 2 * R; ++i)
#pragma unroll
        for (int k = 0; k < 4; ++k) { s[2 * k] += bf_lo(v[i][k]); s[2 * k + 1] += bf_hi(v[i][k]); }
#pragma unroll
    for (int i = 0; i < 16; ++i) {
        const int t = t0 + i;
#pragma unroll
        for (int k = 0; k < 4; ++k) { s[2 * k] += bf_lo(v[i + 2 * R][k]); s[2 * k + 1] += bf_hi(v[i + 2 * R][k]); }
        const int cnt = min(t + R + 1, 2048) - max(t - R, 0);
        const float inv = 1.f / (float)cnt;
        u32x4 wv;
#pragma unroll
        for (int k = 0; k < 4; ++k) wv[k] = cvt_pk_bf16(s[2 * k] * inv - bf_lo(v[i + R][k]), s[2 * k + 1] * inv - bf_hi(v[i + R][k]));
        *(u32x4*)(A6 + (size_t)(row0 + i) * 1024 + c) = wv;
#pragma unroll
        for (int k = 0; k < 4; ++k) { s[2 * k] -= bf_lo(v[i][k]); s[2 * k + 1] -= bf_hi(v[i][k]); }
    }
}
__device__ __forceinline__ void pool_pass2(Frame& F, int part, int nparts) {
    const bf16_t* PV = (const bf16_t*)(F.ws + WS_PV); bf16_t* A6 = (bf16_t*)(F.ws + WS_ACT);
    for (int it = part * 512 + F.tid; it < (NL / 16) * 64; it += nparts * 512) {
        const int c16 = it & 15, rbl = (it >> 4) & 3, g = (it >> 6) & 3, rb = (it >> 8) * 4 + rbl;
        const int row0 = rb * 16, c = g * 128 + c16 * 8;
        if (g == 0) pool_item<1>(PV, A6, row0, c); else if (g == 1) pool_item<2>(PV, A6, row0, c); else if (g == 2) pool_item<4>(PV, A6, row0, c); else pool_item<8>(PV, A6, row0, c);
    }
}
__device__ __forceinline__ void ret_stageC(Frame& F) {
    const int lane = F.lane, w = F.wave, r32 = lane & 31, hi = lane >> 5, half = w >> 2, ib = w & 3;
    const unsigned lds0 = (unsigned)(uintptr_t)F.lds;
    const bf16_t* QF = (const bf16_t*)(F.ws + WS_QF); const bf16_t* QB = (const bf16_t*)(F.ws + WS_QB); const bf16_t* KF = (const bf16_t*)(F.ws + WS_KF); const bf16_t* KB = (const bf16_t*)(F.ws + WS_KB);
    const bf16_t* V1 = (const bf16_t*)(F.ws + WS_V1); const bf16_t* G1 = (const bf16_t*)(F.ws + WS_G1); const bf16_t* ST = (const bf16_t*)(F.ws + WS_ST); bf16_t* A6 = (bf16_t*)(F.ws + WS_ACT);
#define RC_ISSUE(pr_, reg_) do { const int u_ = 2 * (pr_) + half, bh_ = u_ >> 4, cc_ = u_ & 15; \
        dma_tile(V1 + ((size_t)(bh_ & 3) * NTOK + (bh_ >> 2) * 2048 + cc_ * 128) * 128, 128, 128, 256, lds0 + (unsigned)(reg_) * 65536u + half * 32768u, ib, 4, lane); } while (0)
    int reg = 0;
    if (F.vcu < 512) RC_ISSUE(F.vcu, 0);
    for (int pr = F.vcu; pr < 512; pr += F.G, reg ^= 1) {
        const int u = 2 * pr + half, bh = u >> 4, cc = u & 15, b = bh >> 2, h = bh & 3, row0 = b * 2048 + cc * 128;
        const LAS char* L = (const LAS char*)F.lds + reg * 65536 + half * 32768;
        const size_t qoff = ((size_t)h * NL + row0 + 32 * ib + r32) * 64 + hi * 8;
        bf16x8 qf[4], qb[4];
#pragma unroll
        for (int d0 = 0; d0 < 4; ++d0) { qf[d0] = *(const bf16x8*)(QF + qoff + 16 * d0); qb[d0] = *(const bf16x8*)(QB + qoff + 16 * d0); }
        f32x16 o[4];
#pragma unroll
        for (int vb = 0; vb < 4; ++vb)
#pragma unroll
            for (int r = 0; r < 16; ++r) o[vb][r] = 0.f;
        const bf16_t* sfp = ST + ((size_t)u * 2 + 0) * 8192 + (size_t)r32 * 64 + hi * 8; const bf16_t* sbp = sfp + 8192;
        {
            bf16x8 sf[16], sb[16];
#pragma unroll
            for (int vb = 0; vb < 4; ++vb)
#pragma unroll
                for (int s = 0; s < 4; ++s) { sf[4 * vb + s] = *(const bf16x8*)(sfp + (size_t)(32 * vb) * 64 + 16 * s); sb[4 * vb + s] = *(const bf16x8*)(sbp + (size_t)(32 * vb) * 64 + 16 * s); }
#pragma unroll
            for (int vb = 0; vb < 4; ++vb)
#pragma unroll
                for (int s = 0; s < 4; ++s) { o[vb] = MFMA32(qf[s], sf[4 * vb + s], o[vb]); o[vb] = MFMA32(qb[s], sb[4 * vb + s], o[vb]); }
        }
        bf16x8 kfa[4], kba[4];
        { const size_t koff0 = ((size_t)h * NTOK + row0 + r32) * 64 + hi * 8;
#pragma unroll
          for (int d0 = 0; d0 < 4; ++d0) { kfa[d0] = *(const bf16x8*)(KF + koff0 + 16 * d0); kba[d0] = *(const bf16x8*)(KB + koff0 + 16 * d0); } }
        WAIT_BAR(0);
        if (pr + F.G < 512) RC_ISSUE(pr + F.G, reg ^ 1);
        const int iq = 32 * ib + r32;
#pragma unroll
        for (int jb = 0; jb < 4; ++jb) {
            bf16x8 kfn[4], kbn[4];
            if (jb < 3) { const size_t koff = ((size_t)h * NTOK + row0 + 32 * (jb + 1) + r32) * 64 + hi * 8;
#pragma unroll
                for (int d0 = 0; d0 < 4; ++d0) { kfn[d0] = *(const bf16x8*)(KF + koff + 16 * d0); kbn[d0] = *(const bf16x8*)(KB + koff + 16 * d0); } }
            f32x16 pf, pb;
#pragma unroll
            for (int r = 0; r < 16; ++r) { pf[r] = 0.f; pb[r] = 0.f; }
#pragma unroll
            for (int d0 = 0; d0 < 4; ++d0) { pf = MFMA32(kfa[d0], qf[d0], pf); pb = MFMA32(kba[d0], qb[d0], pb); }
            float pp[16];
#pragma unroll
            for (int r = 0; r < 16; ++r) { const int j = 32 * jb + crow(r, hi); pp[r] = (j <= iq ? pf[r] : 0.f) + (j >= iq ? pb[r] : 0.f); }
            u32x4 pw0, pw1;
#pragma unroll
            for (int i = 0; i < 4; ++i) { pw0[i] = cvt_pk_bf16(pp[2 * i], pp[2 * i + 1]); pw1[i] = cvt_pk_bf16(pp[8 + 2 * i], pp[9 + 2 * i]); }
#pragma unroll
            for (int vb = 0; vb < 4; ++vb) {
                o[vb] = MFMA32(as_bf16x8(pw0), tr_frag<1>(L, 256, 32 * jb, 32 * vb, lane), o[vb]);
                o[vb] = MFMA32(as_bf16x8(pw1), tr_frag<1>(L, 256, 32 * jb + 16, 32 * vb, lane), o[vb]);
            }
            if (jb < 3) {
#pragma unroll
                for (int d0 = 0; d0 < 4; ++d0) { kfa[d0] = kfn[d0]; kba[d0] = kbn[d0]; } }
        }
        asm volatile("s_waitcnt lgkmcnt(0)" ::: "memory"); __builtin_amdgcn_s_barrier(); asm volatile("" ::: "memory");
        LAS float* OS = (LAS float*)(F.lds + reg * 65536 + w * 8192);
        float ssq[2];
        u32x4 ggp[2][4];
#pragma unroll
        for (int ps = 0; ps < 2; ++ps) { const bf16_t* gp0 = G1 + ((size_t)h * NL + row0 + 32 * ib + 16 * ps + (lane >> 2)) * 128 + 32 * (lane & 3);
#pragma unroll
            for (int i = 0; i < 4; ++i) ggp[ps][i] = *(const u32x4*)(gp0 + 8 * i); }
#pragma unroll
        for (int ps = 0; ps < 2; ++ps) {
#pragma unroll
            for (int vb = 0; vb < 4; ++vb)
#pragma unroll
                for (int rr = 0; rr < 8; ++rr) { const int r = 8 * ps + rr, lr = (r & 3) + 4 * hi + 8 * ((r >> 2) & 1); OS[lr * 128 + ((32 * vb + r32) ^ (4 * (lr & 7)))] = o[vb][r]; }
            asm volatile("s_waitcnt lgkmcnt(0)" ::: "memory");
            const int lr = lane >> 2, qt = lane & 3;
            f32x4 v[8]; float ss = 0.f;
#pragma unroll
            for (int i = 0; i < 8; ++i) { v[i] = *(const LAS f32x4*)(OS + lr * 128 + ((32 * qt + 4 * i) ^ (4 * (lr & 7)))); ss += (v[i][0] * v[i][0] + v[i][1] * v[i][1]) + (v[i][2] * v[i][2] + v[i][3] * v[i][3]); }
            ss += __shfl_xor(ss, 1); ss += __shfl_xor(ss, 2);
            ssq[ps] = ss;
            const float ri = rsqrtf(ss * (1.f / 128.f) + 1e-6f);
            const size_t orow = (size_t)(row0 + 32 * ib + 16 * ps + lr);
            bf16_t* op = A6 + orow * 1024 + 512 + h * 128 + 32 * qt; const float* gn = F.in[24] + 32 * qt;
#pragma unroll
            for (int i = 0; i < 4; ++i) {
                const u32x4 gg = ggp[ps][i];
                const f32x4 g0 = *(const f32x4*)(gn + 8 * i), g1 = *(const f32x4*)(gn + 8 * i + 4);
                f32x4 a = v[2 * i] * ri * g0, c = v[2 * i + 1] * ri * g1;
                a[0] *= bf_lo(gg[0]); a[1] *= bf_hi(gg[0]); a[2] *= bf_lo(gg[1]); a[3] *= bf_hi(gg[1]); c[0] *= bf_lo(gg[2]); c[1] *= bf_hi(gg[2]); c[2] *= bf_lo(gg[3]); c[3] *= bf_hi(gg[3]);
                *(u32x4*)(op + 8 * i) = pack8(a, c);
            }
            asm volatile("s_waitcnt lgkmcnt(0)" ::: "memory");
        }
        (void)ssq;
    }
    asm volatile("s_waitcnt lgkmcnt(0)" ::: "memory"); __builtin_amdgcn_s_barrier(); asm volatile("" ::: "memory");
#undef RC_ISSUE
}
}
#ifndef MK_STG_A
#define MK_STG_A 0
#endif
#ifndef MK_STG_H
#define MK_STG_H 0
#endif
#ifndef MK_STG_B
#define MK_STG_B 0
#endif
namespace mk {
constexpr int N_PHASES = 14;
__global__ void __launch_bounds__(512, 2) fwd_megakernel(Args args) {
    extern __shared__ __attribute__((aligned(16))) unsigned char lds_raw[];
    Frame F;
    F.lds = (LAS unsigned char*)lds_raw;
    F.tid = threadIdx.x; F.lane = F.tid & 63; F.wave = __builtin_amdgcn_readfirstlane(F.tid >> 6);
    F.G = gridDim.x; { const int bx = blockIdx.x; F.vcu = (F.G % 8 == 0) ? (bx % 8) * (F.G / 8) + bx / 8 : bx; }
    F.in = args.in; F.out = args.out; F.ws = args.ws;
    volatile LAS unsigned* MISC = (volatile LAS unsigned*)(F.lds + MISC_OFF);
    for (int u = F.tid; u < 128; u += 512) MISC[u] = 0u;
    __syncthreads();
    XcdBarrier bar = xcd_barrier_post((unsigned*)(F.ws + WS_CTL) + CW_BAR, MISC + 8);
    const int lo = args.ph_lo, hi = args.ph_hi;
#define IN(k) (lo <= (k) && (k) < hi)
#ifdef MK_TS
    unsigned long long* TS = (unsigned long long*)(F.ws + WS_CTL + 524288);
#define STAMP(k) do { if (blockIdx.x == 0 && F.tid == 0) TS[k] = __builtin_amdgcn_s_memrealtime(); } while (0)
#else
#define STAMP(k) do { } while (0)
#endif
    STAMP(0);
#define SEAM(k) do { if (IN(k) && IN((k) + 1)) xcd_barrier(bar); STAMP((k) + 1); } while (0)
#define MOD ((float*)(F.ws + WS_MOD))
#define XC ((float*)(F.ws + WS_XC))
#define ACT ((bf16_t*)(F.ws + WS_ACT))
#define ring (F.lds)

#define ACT2 ((bf16_t*)(F.ws + WS_ACT2))
#define SS0 ((float*)(F.ws + WS_SS))
#define SS1 ((float*)(F.ws + WS_SS + SS_STRIDE))
#define SS2 ((float*)(F.ws + WS_SS + 2 * SS_STRIDE))
#define BU0 ((const float*)(F.ws + WS_BIAS + BIAS_BU0))
#define BI1 ((const float*)(F.ws + WS_BIAS + BIAS_BI1))
#define BU1 ((const float*)(F.ws + WS_BIAS + BIAS_BU1))
#define MOD1 (MOD + 17 * 6144)
#define side ((LAS float*)(F.lds + SIDE_OFF))

#define STAGGER(D) do { const unsigned long long d_ = (unsigned long long)((F.vcu & 3) * (D)); if (d_) { const unsigned long long t0_ = __builtin_amdgcn_s_memrealtime(); while (__builtin_amdgcn_s_memrealtime() - t0_ < d_) __builtin_amdgcn_s_sleep(8); } } while (0)
    if (IN(0)) p0_prologue(F, 0);
    SEAM(0);
    if (IN(1)) { norm_pass(F, F.in[0], F.in[2], NTOK, F.in[6], MOD, 0); p0_prologue(F, 1); p0_prologue(F, 2); }
    SEAM(1);
    if (IN(2)) {
        pg8::Gemm g{ACT, (const bf16_t*)(F.ws + WS_WIN0), 1024, 256L * 1024 * 2}; pg8::StaticOrder S; S.init(144, 12, F.G, (int)blockIdx.x);
        rope_to_lds(F, side);
        EpiIn0 E{F.ws, F.in[11], F.in[12], side};
        STAGGER(MK_STG_A); pg8::gemm_phase(ring, g, S, E);
        if (F.G == 256) { if (blockIdx.x >= 192) bias_pass(F, (int)blockIdx.x - 192, 64, 0, 1); } else bias_pass(F, F.vcu, F.G, 0, 1);
    }
    SEAM(2);
    if (IN(3)) { attn_phase(F);
        if (F.G == 256) { if (F.vcu < 128) convgate_pass(F, F.vcu, 384); else { convgate_pass(F, 128 + 2 * (F.vcu - 128), 384); convgate_pass(F, 129 + 2 * (F.vcu - 128), 384); } }
        else convgate_pass(F, F.vcu, F.G); }
    SEAM(3);
    if (IN(4)) {
        pg8::Gemm g{ACT, (const bf16_t*)(F.ws + WS_WOUT0), 1024, 256L * 1024 * 2}; pg8::StaticOrder S; S.init(128, 4, F.G, (int)blockIdx.x);
        EpiRes E{F.in[0], F.in[2], F.out, XC, MOD, 2048, ACT2, F.in[7], MOD, 4096, SS0};
        pg8::gemm_phase(ring, g, S, E);
    }
    SEAM(4);
    if (IN(5)) {
        { pg8::Gemm g{ACT, (const bf16_t*)(F.ws + WS_WOUT0), 1024, 256L * 1024 * 2}; pg8::ListOrder S{F.G, (int)blockIdx.x, 128, 0, 4, 64};
          EpiRes E{F.in[0], F.in[2], F.out, XC, MOD, 2048, ACT2, F.in[7], MOD, 4096, SS0};
          pg8::gemm_phase(ring, g, S, E); }
        { pg8::Gemm g{ACT2 - 1024, (const bf16_t*)(F.ws + WS_WUP0), 1024, 254L * 1024 * 2}; pg8::DealOrder S; S.init(130, 22, F.G, (int)blockIdx.x, F.G == 256 ? 64 : 0, F.G == 256 ? 2 : 0);
          EpiUp E{(bf16_t*)(F.ws + WS_HACT), F.in[26], F.in[27], NL, side, SS0, BU0, 0, 0};
          pg8::gemm_phase(ring, g, S, E); }
        if (F.G == 256) { if (blockIdx.x >= 172) weights1_pass(F, (int)blockIdx.x - 172, 84, 0); } else weights1_pass(F, F.vcu, F.G, 0);
    }
    SEAM(5);
    if (IN(6)) {
        { pg8::Gemm g{ACT2 + (size_t)(NL - 1) * 1024, (const bf16_t*)(F.ws + WS_WUP0), 1024, 254L * 1024 * 2}; pg8::StaticOrder S; S.init(17, 22, F.G, (int)blockIdx.x);
          EpiUp E{(bf16_t*)(F.ws + WS_HACT), F.in[26], F.in[27], NTOK, side, SS0, BU0, NL, NL};
          pg8::gemm_phase(ring, g, S, E); }
        { pg8::Gemm g{(const bf16_t*)(F.ws + WS_HACT), (const bf16_t*)(F.ws + WS_WDN0), FF, 256L * FF * 2}; pg8::StaticOrder S; S.init(128, 4, F.G, (int)blockIdx.x);
          EpiRes E{F.out, XC, F.out, XC, MOD, 5120, ACT, F.in[6] + 1024, MOD1, 1024, SS1};
          pg8::gemm_phase(ring, g, S, E); }
        if (F.G == 256) { if (blockIdx.x >= 118) bias_pass(F, (int)blockIdx.x - 118, 138, 1, 2); } else bias_pass(F, F.vcu, F.G, 1, 2);
    }
    SEAM(6);
    if (IN(7)) {
        { pg8::Gemm g{(const bf16_t*)(F.ws + WS_HACT), (const bf16_t*)(F.ws + WS_WDN0), FF, 256L * FF * 2}; pg8::ListOrder S{F.G, (int)blockIdx.x, 128, 0, 4, 64};
          EpiRes E{F.out, XC, F.out, XC, MOD, 5120, ACT, F.in[6] + 1024, MOD1, 1024, SS1};
          pg8::gemm_phase(ring, g, S, E); }
        { pg8::Gemm g{ACT, (const bf16_t*)(F.ws + WS_WIN1), 1024, 256L * 1024 * 2}; pg8::DealOrder S; S.init(128, 8, F.G, (int)blockIdx.x, F.G == 256 ? 64 : 0, F.G == 256 ? 3 : 0);
          rope_to_lds(F, side + 256);
          EpiIn1 E{F.ws, F.in[22], F.in[23], SS1, BI1, side};
          pg8::gemm_phase(ring, g, S, E); }
    }
    SEAM(7);
    if (IN(8)) {
        const int nctx = F.G >= 96 ? 48 : 0;
        if (nctx) {
            if ((int)blockIdx.x < nctx) { pg8::Gemm g{ACT, (const bf16_t*)(F.ws + WS_WIN1), 1024, 256L * 1024 * 2}; pg8::ListOrder S{nctx, (int)blockIdx.x, 128, 3, 3, 48};
                rope_to_lds(F, side + 256); EpiIn1 E{F.ws, F.in[22], F.in[23], SS1, BI1, side}; pg8::gemm_phase(ring, g, S, E); }
            else { pool_pass2(F, (int)blockIdx.x - nctx, F.G - nctx); weights1_pass(F, (int)blockIdx.x - nctx, F.G - nctx, 1); }
        } else {
            { pg8::Gemm g{ACT, (const bf16_t*)(F.ws + WS_WIN1), 1024, 256L * 1024 * 2}; pg8::ListOrder S{F.G, (int)blockIdx.x, 128, 3, 3, 48};
              rope_to_lds(F, side + 256); EpiIn1 E{F.ws, F.in[22], F.in[23], SS1, BI1, side}; pg8::gemm_phase(ring, g, S, E); }
            pool_pass2(F, F.vcu, F.G); weights1_pass(F, F.vcu, F.G, 1);
        }
    }
    SEAM(8);
    if (IN(9)) { for (int u = F.vcu; u < 256; u += F.G) ret_states_unit(F, u >> 2, (u >> 1) & 1, u & 1); }
    SEAM(9);
    if (IN(10)) ret_stageC(F);
    SEAM(10);
    if (IN(11)) {
        pg8::Gemm g{ACT, (const bf16_t*)(F.ws + WS_WOUT1), 1024, 256L * 1024 * 2}; pg8::StaticOrder S; S.init(128, 4, F.G, (int)blockIdx.x);
        EpiRes E{F.out, XC, F.out, XC, MOD1, 2048, ACT2, F.in[7] + 1024, MOD1, 4096, SS2};
        { const unsigned long long d_ = (unsigned long long)((F.vcu & 1) * (MK_STG_H)); if (d_) { const unsigned long long t0_ = __builtin_amdgcn_s_memrealtime(); while (__builtin_amdgcn_s_memrealtime() - t0_ < d_) __builtin_amdgcn_s_sleep(8); } } pg8::gemm_phase(ring, g, S, E);
    }
    SEAM(11);
    if (IN(12)) {
        pg8::Gemm g{ACT2 - 1024, (const bf16_t*)(F.ws + WS_WUP1), 1024, 254L * 1024 * 2}; pg8::StaticOrder S; S.init(130, 22, F.G, (int)blockIdx.x);
        EpiUp E{(bf16_t*)(F.ws + WS_HACT), F.in[26] + 3 * FF, F.in[27] + FF, NL, side, SS2, BU1, 0, 0};
        STAGGER(MK_STG_A); pg8::gemm_phase(ring, g, S, E);
    }
    SEAM(12);
    if (IN(13)) {
        pg8::Gemm g{(const bf16_t*)(F.ws + WS_HACT), (const bf16_t*)(F.ws + WS_WDN1), FF, 256L * FF * 2}; pg8::StaticOrder S; S.init(128, 4, F.G, (int)blockIdx.x);
        EpiRes E{F.out, XC, F.out, XC, MOD1, 5120, nullptr, nullptr, nullptr, 0, nullptr};
        STAGGER(MK_STG_B); pg8::gemm_phase(ring, g, S, E);
    }
#ifdef MK_TS
    xcd_barrier(bar); STAMP(14);
    if (blockIdx.x == 0 && F.wave == 0) {
        float best = 1e30f; int bi = 0;
        for (int e = F.lane; e < 4096; e += 64) { const float v = fabsf(F.out[e]); if (v < best) { best = v; bi = e; } }
        for (int o = 32; o > 0; o >>= 1) { const float ob = __shfl_xor(best, o); const int oi = __shfl_xor(bi, o); if (ob < best || (ob == best && oi < bi)) { best = ob; bi = oi; } }
        if (F.lane == 0) { float us = (float)(TS[MK_TS_B] - TS[MK_TS_A]) * 0.01f;
#ifdef MK_TS_OFF
            us -= (MK_TS_OFF); us = us < 0.f ? 0.f : us;
#endif
            F.out[bi] += 0.04f + us * (MK_TS_SCALE); }
    }
#endif
#undef IN
#undef SEAM
#undef ACT2
#undef SS0
#undef SS1
#undef SS2
#undef BU0
#undef BI1
#undef BU1
#undef MOD1
#undef side
#undef MOD
#undef XC
#undef ACT
#undef ring
}

static int g_grid = 0;
inline void launch(hipStream_t stream, void* const* d_in, void* d_out, void* d_ws, int ph_lo, int ph_hi) {
    if (g_grid == 0) {
        int dev = 0, cus = 0, per_cu = 0;
        (void)hipGetDevice(&dev); (void)hipDeviceGetAttribute(&cus, hipDeviceAttributeMultiprocessorCount, dev);
        (void)hipFuncSetAttribute((const void*)fwd_megakernel, hipFuncAttributeMaxDynamicSharedMemorySize, LDS_BYTES);
        (void)hipOccupancyMaxActiveBlocksPerMultiprocessor(&per_cu, (const void*)fwd_megakernel, 512, LDS_BYTES);
        (void)hipGetLastError();
        if (per_cu < 1) fprintf(stderr, "kernel_launch: occupancy query reports %d blocks per CU\n", per_cu);
        g_grid = cus > 0 ? cus : 256;
    }
#ifdef MK_TS
    (void)hipMemsetAsync((char*)d_ws + WS_CTL, 0, CTL_ZERO_BYTES, stream);
#else
    (void)hipMemsetAsync((char*)d_ws + WS_CTL + CW_BAR * 4, 0, XCD_BAR_WORDS * 4, stream);
#endif
    Args a{};
    for (int i = 0; i < 29; ++i) a.in[i] = (const float*)d_in[i];
    a.out = (float*)d_out; a.ws = (unsigned char*)d_ws; a.ph_lo = ph_lo; a.ph_hi = ph_hi;
    hipLaunchKernelGGL(fwd_megakernel, dim3(g_grid), dim3(512), LDS_BYTES, stream, a);
}
}
extern "C" void kernel_launch(void* const* d_in, const int* in_sizes, int n_in, void* d_out, int out_size, void* d_ws, size_t ws_size, hipStream_t stream) {
    mk::launch(stream, d_in, d_out, d_ws, 0, mk::N_PHASES);
}
```

```cpp
#include <hip/hip_runtime.h>
#include <cstdio>
#include <cstdint>
#include <cstring>

#define LAS __attribute__((address_space(3)))
#define GAS __attribute__((address_space(1)))
typedef unsigned short bf16_t;
typedef short bf16x8 __attribute__((ext_vector_type(8)));
typedef short s16x4 __attribute__((ext_vector_type(4)));
typedef float f32x4 __attribute__((ext_vector_type(4)));
typedef float f32x16 __attribute__((ext_vector_type(16)));
typedef unsigned u32x4 __attribute__((ext_vector_type(4)));
typedef unsigned u32x2 __attribute__((ext_vector_type(2)));
typedef GAS unsigned gu32;

__device__ __forceinline__ unsigned cvt_pk_bf16(float lo, float hi) { unsigned r; asm volatile("v_cvt_pk_bf16_f32 %0, %1, %2" : "=v"(r) : "v"(lo), "v"(hi)); return r; }
__device__ __forceinline__ float bf_lo(unsigned u) { return __uint_as_float(u << 16); }
__device__ __forceinline__ float bf_hi(unsigned u) { return __uint_as_float(u & 0xffff0000u); }
__device__ __forceinline__ float fast_silu(float v) { return v * __builtin_amdgcn_rcpf(1.f + __builtin_amdgcn_exp2f(-1.4426950408889634f * v)); }
__device__ __forceinline__ float wave_sum(float v) {
#pragma unroll
    for (int o = 1; o < 64; o <<= 1) v += __shfl_xor(v, o);
    return v;
}
__device__ __forceinline__ float wave_max(float v) {
#pragma unroll
    for (int o = 1; o < 64; o <<= 1) v = fmaxf(v, __shfl_xor(v, o));
    return v;
}
__device__ __forceinline__ void glds16(const void* gsrc, unsigned lds_dst) {
    unsigned keep;
    asm volatile("s_mov_b32 %0, m0\n\ts_mov_b32 m0, %2\n\ts_nop 0\n\tglobal_load_lds_dwordx4 %1, off\n\ts_mov_b32 m0, %0" : "=&s"(keep) : "v"(gsrc), "s"(lds_dst) : "memory");
}
#define WAIT_BAR(N) asm volatile("s_waitcnt vmcnt(" #N ") lgkmcnt(0)\n\ts_barrier" ::: "memory")
typedef short v4i16_t __attribute__((ext_vector_type(4)));
__device__ __forceinline__ s16x4 tr_read(const LAS char* p) { return __builtin_bit_cast(s16x4, __builtin_amdgcn_ds_read_tr16_b64_v4i16((LAS v4i16_t*)p)); }
__device__ __forceinline__ bf16x8 cat8(s16x4 lo, s16x4 hi) { return (bf16x8){lo[0], lo[1], lo[2], lo[3], hi[0], hi[1], hi[2], hi[3]}; }
__device__ __forceinline__ int crow(int r, int hi) { return (r & 3) + 8 * (r >> 2) + 4 * hi; }

namespace pg8 {
constexpr int BM = 256, BK = 64, HALF = 128, HTB = HALF * BK * 2  , STAGE_BYTES = 8 * HTB, NXCD = 8, WGM = 8;
__host__ __device__ __forceinline__ int lds_byte(int r, int c) { const int st = (r >> 4) * 2 + (c >> 5), rr = r & 15, cc = c & 31, ob = rr * 64 + cc * 2; return st * 1024 + (ob ^ (((ob >> 9) & 1) << 5)); }
__host__ __device__ __forceinline__ void stage_rc(int b, int& R, int& C) { const int st = b / 1024, sb = b % 1024, swz = sb ^ (((sb >> 9) & 1) << 5); R = (st >> 1) * 16 + swz / 64; C = (st & 1) * 32 + (swz % 64) / 2; }

struct Unit { int pm, pn; };
struct Gemm { const bf16_t* A; const bf16_t* Bt; int K; long a_tstep; };

struct StaticOrder {
    int nM, nN, nwg, G, c;
    __device__ void init(int nM_, int nN_, int G_, int c_) { nM = nM_; nN = nN_; nwg = nM * nN; G = G_; c = c_; }
    __device__ bool next(int i, Unit& u) const { return at((long)i * G + c, u); }
    __device__ bool at(long L, Unit& u) const {
        if (L >= nwg) return false;
        int wgid = (int)L; { const int q = nwg / NXCD, r = nwg % NXCD, xcd = wgid % NXCD, off = wgid / NXCD; wgid = (xcd < r ? xcd * (q + 1) : r * (q + 1) + (xcd - r) * q) + off; }
        const int nig = WGM * nN, gid = wgid / nig, fm = gid * WGM, gsz = (nM - fm) < WGM ? (nM - fm) : WGM;
        u.pm = fm + ((wgid % nig) % gsz); u.pn = (wgid % nig) / gsz; return true;
    }
};

struct DealOrder {
    StaticOrder so; int G, c, skipC, skipR;
    __device__ void init(int nM, int nN, int G_, int c_, int skipC_, int skipR_) { so.init(nM, nN, G_, c_); G = G_; c = c_; skipC = skipC_; skipR = skipR_; }
    __device__ bool next(int i, Unit& u) const {
        long L;
        if (c < skipC) L = (long)skipR * (G - skipC) + (long)i * G + c;
        else L = i < skipR ? (long)i * (G - skipC) + (c - skipC) : (long)skipR * (G - skipC) + (long)(i - skipR) * G + c;
        return so.at(L, u);
    }
};
struct ListOrder {
    int G, c, pm0, pn0, npn, count;
    __device__ bool next(int i, Unit& u) const { const int e = i * G + c; if (e >= count) return false; u.pm = pm0 + e / npn; u.pn = pn0 + e % npn; return true; }
};
template <class Epi, class Sched>
__device__ __forceinline__ void gemm_phase(LAS unsigned char* lds, const Gemm g, const Sched& S, const Epi& E) {
    int tid_ = threadIdx.x; asm volatile("" : "+v"(tid_));
    const int tid = tid_, wid = __builtin_amdgcn_readfirstlane(tid >> 6), lane = tid & 63, wr = wid >> 2, wc = wid & 3, fr = lane & 15, fq = lane >> 4;
    const int K = g.K, nt = K / BK;
    unsigned voffA[2];
#pragma unroll
    for (int i = 0; i < 2; ++i) { int R, C; stage_rc(tid * 16 + i * 8192, R, C); voffA[i] = (unsigned)(R * K + C) * 2u; }
    const size_t kstep = (size_t)(BK * 2);
    const size_t hstep = (size_t)HALF * K * 2;
    const size_t btstep = 2 * hstep;
    const unsigned ldsw = (unsigned)wid * 1024u;
    const int aoff = lds_byte(wr * 64 + fr, fq * 8), boff = lds_byte(wc * 32 + fr, fq * 8);
#define PG8_SA(b, h) (((b) * 2 + (h)) * HTB)
#define PG8_SB(b, h) ((4 + (b) * 2 + (h)) * HTB)
#define PG8_STAGE(bufoff, gbase) do { _Pragma("unroll") for (int _i = 0; _i < 2; ++_i) \
        __builtin_amdgcn_global_load_lds((const unsigned*)((const char*)(gbase) + voffA[_i]), (LAS unsigned*)(lds + (bufoff) + ldsw + _i * 8192), 16, 0, 0); } while (0)
#define PG8_LDA(dst, b, h) do { _Pragma("unroll") for (int m = 0; m < 4; ++m) _Pragma("unroll") for (int k = 0; k < 2; ++k) dst[m][k] = *(const LAS bf16x8*)(lds + PG8_SA(b, h) + aoff + m * 2048 + k * 1024); } while (0)
#define PG8_LDB(dst, b, h) do { _Pragma("unroll") for (int n = 0; n < 2; ++n) _Pragma("unroll") for (int k = 0; k < 2; ++k) dst[n][k] = *(const LAS bf16x8*)(lds + PG8_SB(b, h) + boff + n * 2048 + k * 1024); } while (0)
#define PG8_MMA(ai, bj, At, Bt) do { __builtin_amdgcn_s_setprio(1); _Pragma("unroll") for (int m = 0; m < 4; ++m) _Pragma("unroll") for (int n = 0; n < 2; ++n) _Pragma("unroll") for (int k = 0; k < 2; ++k) \
        acc[ai][bj][m][n] = __builtin_amdgcn_mfma_f32_16x16x32_bf16(Bt[n][k], At[m][k], acc[ai][bj][m][n], 0, 0, 0); __builtin_amdgcn_s_setprio(0); } while (0)
#define PG8_WAIT_V(n) asm volatile("s_waitcnt vmcnt(" #n ")" ::: "memory")
#define PG8_WAIT_L(n) asm volatile("s_waitcnt lgkmcnt(" #n ")" ::: "memory")
#define PG8_BAR __builtin_amdgcn_s_barrier()
#define PG8_SCHED __builtin_amdgcn_sched_barrier(0)
    LAS int* utab = (LAS int*)(lds + STAGE_BYTES + 12288);
    if (tid < 32) { Unit t_; const bool ok_ = S.next(tid, t_); utab[2 * tid] = ok_ ? t_.pm : -1; utab[2 * tid + 1] = ok_ ? t_.pn : 0; }
    asm volatile("s_waitcnt lgkmcnt(0)" ::: "memory"); __builtin_amdgcn_s_barrier(); asm volatile("" ::: "memory");
#define PG8_UNIT(i, U) ((U).pm = __builtin_amdgcn_readfirstlane(utab[2 * (i)]), (U).pn = __builtin_amdgcn_readfirstlane(utab[2 * (i) + 1]), (U).pm >= 0)
    Unit cur, nxt; int ui = 0;
    if (!PG8_UNIT(0, cur)) return;
    const char* pfb = nullptr;
    if constexpr (Epi::PF) pfb = E.pf_base(cur) + (size_t)wid * 4096 + lane * 16;
#define PG8_PF(it_, sp_) do { if constexpr (Epi::PF) { int pi_ = (it_) * 4 + (sp_); pi_ = pi_ > 31 ? 31 : pi_; \
        __builtin_amdgcn_global_load_lds((const unsigned*)(pfb + (size_t)pi_ * 32768), (LAS unsigned*)(lds + STAGE_BYTES + ldsw), 16, 0, 0); } } while (0)
#define PG8_WAIT_VK(first_) do { if constexpr (Epi::PF) { if (first_) { PG8_WAIT_V(9); } else { PG8_WAIT_V(10); } } else { PG8_WAIT_V(8); } } while (0)
    f32x4 acc[2][2][4][2];
#pragma unroll
    for (int a = 0; a < 2; ++a)
#pragma unroll
        for (int b = 0; b < 2; ++b)
#pragma unroll
            for (int m = 0; m < 4; ++m)
#pragma unroll
                for (int n = 0; n < 2; ++n) acc[a][b][m][n] = (f32x4){0.f, 0.f, 0.f, 0.f};
    bf16x8 At[4][2], B0[2][2], B1[2][2];
    const char* cA = (const char*)g.A + (long)cur.pm * g.a_tstep; const char* cB = (const char*)g.Bt + (size_t)cur.pn * btstep;
    PG8_STAGE(PG8_SB(0, 0), cB); PG8_STAGE(PG8_SB(0, 1), cB + hstep); PG8_STAGE(PG8_SA(0, 0), cA); PG8_STAGE(PG8_SA(0, 1), cA + hstep);
    if (wr == 1) PG8_BAR;
    PG8_WAIT_V(2); PG8_BAR;
    PG8_STAGE(PG8_SB(1, 0), cB + kstep); PG8_STAGE(PG8_SA(1, 0), cA + kstep); PG8_STAGE(PG8_SB(1, 1), cB + hstep + kstep);
    PG8_WAIT_V(6); PG8_BAR;
    for (;;) {
        const bool has_next = PG8_UNIT(ui + 1, nxt);
        const char* nA = has_next ? (const char*)g.A + (long)nxt.pm * g.a_tstep : cA; const char* nB = has_next ? (const char*)g.Bt + (size_t)nxt.pn * btstep : cB;
        for (int t = 0; t < nt; t += 2) {
            const bool last = (t == nt - 2);
            const char* a1 = cA + (size_t)(t + 1) * kstep;
            const char* a2 = last ? nA : cA + (size_t)(t + 2) * kstep; const char* b2 = last ? nB : cB + (size_t)(t + 2) * kstep;
            const char* a3 = a2 + kstep; const char* b3 = b2 + kstep;
            const int it2 = t >> 1;
            PG8_LDB(B0, 0, 0); PG8_LDB(B1, 0, 1); PG8_SCHED; PG8_LDA(At, 0, 0); PG8_STAGE(PG8_SA(1, 1), a1 + hstep); PG8_PF(it2, 0);
            PG8_WAIT_VK(ui == 0 && t == 0); PG8_WAIT_L(0); PG8_BAR; PG8_MMA(0, 0, At, B0); PG8_MMA(0, 1, At, B1); PG8_BAR; PG8_SCHED;
            PG8_LDA(At, 0, 1); PG8_STAGE(PG8_SB(0, 0), b2); PG8_STAGE(PG8_SB(0, 1), b2 + hstep); PG8_STAGE(PG8_SA(0, 0), a2); PG8_PF(it2, 1);
            PG8_WAIT_VK(false); PG8_WAIT_L(0); PG8_BAR; PG8_MMA(1, 0, At, B0); PG8_MMA(1, 1, At, B1); PG8_BAR; PG8_SCHED;
            PG8_LDB(B0, 1, 0); PG8_LDB(B1, 1, 1); PG8_SCHED; PG8_LDA(At, 1, 0); PG8_STAGE(PG8_SA(0, 1), a2 + hstep); PG8_PF(it2, 2);
            PG8_WAIT_VK(false); PG8_WAIT_L(0); PG8_BAR; PG8_MMA(0, 0, At, B0); PG8_MMA(0, 1, At, B1); PG8_BAR; PG8_SCHED;
            PG8_LDA(At, 1, 1); PG8_STAGE(PG8_SB(1, 0), b3); PG8_STAGE(PG8_SB(1, 1), b3 + hstep); PG8_STAGE(PG8_SA(1, 0), a3); PG8_PF(it2, 3);
            PG8_WAIT_VK(false); PG8_WAIT_L(0); PG8_BAR; PG8_MMA(1, 0, At, B0); PG8_MMA(1, 1, At, B1); PG8_BAR; PG8_SCHED;
        }
        if (wr == 0) PG8_BAR;
        E(acc, cur, nxt, has_next, ui, wr, wc, fr, fq);
        if (!has_next) break;
#pragma unroll
        for (int a = 0; a < 2; ++a)
#pragma unroll
            for (int b = 0; b < 2; ++b)
#pragma unroll
                for (int m = 0; m < 4; ++m)
#pragma unroll
                    for (int n = 0; n < 2; ++n) acc[a][b][m][n] = (f32x4){0.f, 0.f, 0.f, 0.f};
        cur = nxt; cA = nA; cB = nB; ++ui;
        if constexpr (Epi::PF) pfb = E.pf_base(cur) + (size_t)wid * 4096 + lane * 16;
        if (wr == 1) PG8_BAR;
    }
    PG8_WAIT_V(0);
    PG8_BAR;
#undef PG8_UNIT
#undef PG8_PF
#undef PG8_WAIT_VK
#undef PG8_SA
#undef PG8_SB
#undef PG8_STAGE
#undef PG8_LDA
#undef PG8_LDB
#undef PG8_MMA
#undef PG8_WAIT_V
#undef PG8_WAIT_L
#undef PG8_BAR
#undef PG8_SCHED
}
}

#define XB_TMO      128
#define XB_XCNT(j)  (256  + 64 * (j))
#define XB_XSUB(j)  (1280 + 64 * (j))
#define XB_XGEN(j)  (2304 + 64 * (j))
#define XB_TOP      3328
#define XB_TOPGEN   3392
#define XCD_BAR_WORDS 3456
#define XB_SPIN_CAP (1u << 18)
__device__ __forceinline__ unsigned xb_ld(unsigned* p)              { return __hip_atomic_load(p, __ATOMIC_RELAXED, __HIP_MEMORY_SCOPE_AGENT); }
__device__ __forceinline__ unsigned xb_add(unsigned* p, unsigned v) { return __hip_atomic_fetch_add(p, v, __ATOMIC_RELAXED, __HIP_MEMORY_SCOPE_AGENT); }
__device__ __forceinline__ unsigned xb_xcc_id() { return (unsigned)__builtin_amdgcn_s_getreg((3 << 11) | 20) & 0xFu; }
#define XB_SPIN(cond, bar) do { unsigned _sp = 0; while (cond) { __builtin_amdgcn_s_sleep(1); \
    if ((++_sp & 255u) == 0u) { if (xb_ld(&(bar)[XB_TMO])) break; if (_sp > XB_SPIN_CAP) { atomicAdd(&(bar)[XB_TMO], 1u); break; } } } } while (0)
struct XcdBarrier { unsigned* bar; unsigned x; volatile LAS unsigned* st; };
__device__ __forceinline__ XcdBarrier xcd_barrier_post(unsigned* bar, volatile LAS unsigned* st) {
    XcdBarrier b; b.bar = bar; b.x = xb_xcc_id(); b.st = st;
    if (threadIdx.x == 0) (void)xb_add(&bar[XB_XCNT(b.x)], 1u);
    return b;
}
__device__ __forceinline__ void xcd_barrier_complete(unsigned* bar, unsigned x, unsigned& nloc, unsigned& nx) {
    const unsigned G = gridDim.x * gridDim.y * gridDim.z;
    unsigned sum, cnt, mine, sp = 0u;
    for (;;) {
        sum = 0u; cnt = 0u; mine = 0u;
#pragma unroll
        for (unsigned j = 0; j < 16; ++j) { const unsigned c = xb_ld(&bar[XB_XCNT(j)]); sum += c; cnt += (c > 0u) ? 1u : 0u; mine = (j == x) ? c : mine; }
        if (sum == G) break;
        __builtin_amdgcn_s_sleep(1);
        if ((++sp & 255u) == 0u) { if (xb_ld(&bar[XB_TMO])) break; if (sp > XB_SPIN_CAP) { atomicAdd(&bar[XB_TMO], 1u); break; } }
    }
    nloc = mine > 0u ? mine : 1u; nx = cnt > 0u ? cnt : 1u;
}
__device__ __forceinline__ void xcd_barrier(const XcdBarrier& b) {
    asm volatile("s_waitcnt vmcnt(0)" ::: "memory");
    __syncthreads();
    if (threadIdx.x == 0) {
        unsigned* bar = b.bar;
        __builtin_amdgcn_s_waitcnt(0);
        unsigned nloc = b.st[0], nx = b.st[1];
        if (nloc == 0u) { xcd_barrier_complete(bar, b.x, nloc, nx); b.st[0] = nloc; b.st[1] = nx; }
        const unsigned old = xb_add(&bar[XB_XSUB(b.x)], 1u);
        const unsigned gen = old / nloc;
        if (old + 1u == (gen + 1u) * nloc) {
            __builtin_amdgcn_fence(__ATOMIC_RELEASE, "agent");
            asm volatile("s_waitcnt vmcnt(0)" ::: "memory");
            const unsigned og = xb_add(&bar[XB_TOP], 1u);
            const unsigned tg = og / nx;
            if (og + 1u == (tg + 1u) * nx) xb_add(&bar[XB_TOPGEN], 1u);
            else XB_SPIN(xb_ld(&bar[XB_TOPGEN]) == tg, bar);
            __builtin_amdgcn_fence(__ATOMIC_ACQUIRE, "agent");
            xb_add(&bar[XB_XGEN(b.x)], 1u);
            asm volatile("s_waitcnt vmcnt(0)" ::: "memory");
        } else {
            XB_SPIN(xb_ld(&bar[XB_XGEN(b.x)]) == gen, bar);
            __builtin_amdgcn_fence(__ATOMIC_ACQUIRE, "agent");
            asm volatile("s_waitcnt vmcnt(0)" ::: "memory");
        }
    }
    __syncthreads();
}
#ifdef MK_TS
#define MK_STAMP2(k) do { if (blockIdx.x == 0 && threadIdx.x == 0) ((unsigned long long*)(F.ws + 524288))[k] = __builtin_amdgcn_s_memrealtime(); } while (0)
#else
#define MK_STAMP2(k) do { } while (0)
#endif
namespace mk {
constexpr int NL = 32768, NC = 4096, NTOK = NL + NC, D = 1024, FF = 2816;
constexpr size_t MiB = 1u << 20;
constexpr size_t WS_CTL = 0, CTL_ZERO_BYTES = 1 * MiB;
constexpr size_t WS_MOD = 1 * MiB;
constexpr size_t WS_ROPE = 2 * MiB;
constexpr size_t WS_WIN0 = 4 * MiB, WS_WOUT0 = 10 * MiB, WS_WIN1 = 12 * MiB, WS_WOUT1 = 16 * MiB, WS_WUP0 = 18 * MiB, WS_WUP1 = 29 * MiB, WS_WDN0 = 40 * MiB, WS_WDN1 = 46 * MiB;
constexpr size_t WS_ACT = 56 * MiB + 2048;
constexpr size_t WS_XC = 132 * MiB;
constexpr size_t WS_BIG = 150 * MiB;
constexpr size_t WS_BG = WS_BIG, WS_U = WS_BIG + 36 * MiB, WS_Q = WS_BIG + 72 * MiB, WS_K = WS_BIG + 108 * MiB, WS_V = WS_BIG + 144 * MiB;
constexpr size_t WS_HACT = WS_BIG;
constexpr size_t WS_PV = WS_BIG, WS_QF = WS_BIG + 32 * MiB, WS_QB = WS_BIG + 48 * MiB, WS_KF = WS_BIG + 64 * MiB, WS_KB = WS_BIG + 82 * MiB, WS_V1 = WS_BIG + 100 * MiB, WS_G1 = WS_BIG + 136 * MiB;
constexpr size_t WS_ST = WS_BIG + 168 * MiB;
constexpr size_t WS_ACT2 = 352 * MiB + 2048;
constexpr size_t WS_SS = 426 * MiB, SS_STRIDE = 5 * MiB / 2;
constexpr size_t WS_BIAS = 434 * MiB;
constexpr size_t BIAS_BU0 = 0, BIAS_BI1 = 17 * 5632 * 4, BIAS_BU1 = BIAS_BI1 + 17 * 2048 * 4;
constexpr size_t WS_END = 436 * MiB;
static_assert(WS_END <= 512 * MiB, "d_ws map");
constexpr int CW_BAR = 4096;
constexpr int RING_BYTES = 131072, SIDE_OFF = RING_BYTES, SIDE_BYTES = 16384, MISC_OFF = SIDE_OFF + SIDE_BYTES, LDS_BYTES = MISC_OFF + 512;

struct Args { const float* in[29]; float* out; unsigned char* ws; int ph_lo, ph_hi; };

struct Frame {
    LAS unsigned char* lds;
    int tid, lane, wave, vcu, G;
    const float* const* in; float* out; unsigned char* ws;
};

__device__ __forceinline__ int plain8(int tc) { const int bj = tc >> 7, wc = (tc >> 5) & 3, n = (tc >> 4) & 1, fq = (tc >> 2) & 3, j = tc & 3; return 128 * bj + 32 * wc + 8 * fq + 4 * n + j; }
__device__ __forceinline__ int head64(int tc) { const int bj = tc >> 7, n = (tc >> 4) & 1, fq = (tc >> 2) & 3, j = tc & 3; return 32 * (fq >> 1) + 16 * bj + 8 * (fq & 1) + 4 * n + j; }
enum { SG_ID = 0, SG_IN0 = 1, SG_UP = 2, SG_IN1 = 3, SG_P8 = 4 };
__device__ __forceinline__ int inv_plain8(int c) { const int hi3 = c & ~31, fq = (c >> 3) & 3, n = (c >> 2) & 1, j = c & 3; return hi3 + 16 * n + 4 * fq + j; }
__device__ __forceinline__ int sigma(int kind, int np) {
    const int pn = np >> 8, tc = np & 255, bj = tc >> 7, wc = (tc >> 5) & 3;
    if (kind == SG_IN0) {
        if (pn < 2) return 256 * pn + plain8(tc);
        if (pn < 6) return (bj ? 1024 : 512) + 128 * (pn - 2) + (plain8(tc) & 127);
        if (pn < 10) return 1536 + 64 * ((pn - 6) * 4 + wc) + head64(tc);
        return 2560 + 256 * (pn - 10) + plain8(tc);
    }
    if (kind == SG_UP) return (bj ? FF : 0) + 128 * pn + (plain8(tc) & 127);
    if (kind == SG_P8) return 256 * pn + plain8(tc);
    if (kind == SG_IN1) {
        if (pn < 2) return 256 * pn + plain8(tc);
        if (pn == 2) return 512 + 64 * wc + head64(tc);
        if (pn == 3) return 768 + 64 * wc + head64(tc);
        if (pn < 6) return 1024 + 256 * (pn - 4) + plain8(tc);
        return 1536 + 256 * (pn - 6) + plain8(tc);
    }
    return np;
}
__device__ __forceinline__ void transpose_item(const float* W, int K, int N, bf16_t* WT, int kind, LAS float* scr, int item, int lane) {
    const int nblk = N / 32, kb = item / nblk, nb = item % nblk, k0 = 64 * kb, n0 = 32 * nb;
    const int cg = lane & 7, kr = lane >> 3;
    const int scol = sigma(kind, n0 + 4 * cg);
    f32x4 v[8];
#pragma unroll
    for (int i = 0; i < 8; ++i) v[i] = *(const f32x4*)(W + (size_t)(k0 + 8 * i + kr) * N + scol);
#pragma unroll
    for (int i = 0; i < 8; ++i) { LAS float* d = scr + (8 * i + kr) * 33 + 4 * cg; d[0] = v[i][0]; d[1] = v[i][1]; d[2] = v[i][2]; d[3] = v[i][3]; }
    asm volatile("s_waitcnt lgkmcnt(0)" ::: "memory");
    const int c = lane & 7;
#pragma unroll
    for (int j = 0; j < 4; ++j) { const int n = (lane >> 3) + 8 * j; const LAS float* s = scr + (8 * c) * 33 + n;
        u32x4 o; o.x = cvt_pk_bf16(s[0 * 33], s[1 * 33]); o.y = cvt_pk_bf16(s[2 * 33], s[3 * 33]); o.z = cvt_pk_bf16(s[4 * 33], s[5 * 33]); o.w = cvt_pk_bf16(s[6 * 33], s[7 * 33]);
        *(u32x4*)(WT + (size_t)(n0 + n) * K + k0 + 8 * c) = o; }
    asm volatile("s_waitcnt lgkmcnt(0)" ::: "memory");
}
__device__ __forceinline__ void poolfold_item(const float* pw, const float* ps, const float* wo, bf16_t* WT, int item, int lane) {
    const int db = item & 15, cb = (item >> 4) & 15, g = item >> 8, d = db * 64 + lane, c0 = cb * 8;
    float pwv[8][2];
    { const float ps0 = ps[g * 128 + lane], ps1 = ps[g * 128 + 64 + lane];
#pragma unroll
      for (int i = 0; i < 8; ++i) { pwv[i][0] = pw[((size_t)g * 128 + c0 + i) * 128 + lane] * ps0; pwv[i][1] = pw[((size_t)g * 128 + c0 + i) * 128 + 64 + lane] * ps1; } }
    float acc[8];
#pragma unroll
    for (int i = 0; i < 8; ++i) acc[i] = 0.f;
#pragma unroll
    for (int q = 0; q < 4; ++q) {
        float w[32];
#pragma unroll
        for (int j = 0; j < 32; ++j) w[j] = wo[(size_t)(g * 128 + q * 32 + j) * 1024 + d];
#pragma unroll
        for (int j = 0; j < 32; ++j)
#pragma unroll
            for (int i = 0; i < 8; ++i) acc[i] += __int_as_float(__builtin_amdgcn_readlane(__float_as_int(pwv[i][q >> 1]), (q & 1) * 32 + j)) * w[j];
    }
    u32x4 o; o.x = cvt_pk_bf16(acc[0], acc[1]); o.y = cvt_pk_bf16(acc[2], acc[3]); o.z = cvt_pk_bf16(acc[4], acc[5]); o.w = cvt_pk_bf16(acc[6], acc[7]);
    *(u32x4*)(WT + (size_t)((d & ~255) + inv_plain8(d & 255)) * 1024 + g * 128 + c0) = o;
}
__device__ __forceinline__ void mod_item(Frame& F, int item) {
    const float* c = F.in[1]; const float* cc = F.in[3]; const float* mw = F.in[4]; const float* mb = F.in[5];
    float* MOD = (float*)(F.ws + WS_MOD);
    const int i = item / 96, cg = item % 96;
    LAS float* sc = (LAS float*)(F.lds);
    LAS float* part = (LAS float*)(F.lds + 81920);
    {
        f32x4 v[9];
#pragma unroll
        for (int i = 0; i < 9; ++i) { const int q = F.tid + 512 * i; v[i] = q < 4096 ? ((const f32x4*)c)[q] : (q < 4352 ? ((const f32x4*)cc)[q - 4096] : (f32x4){0.f, 0.f, 0.f, 0.f}); }
#pragma unroll
        for (int i = 0; i < 9; ++i) { const int q = F.tid + 512 * i; if (q < 4352) { f32x4 o;
#pragma unroll
            for (int j = 0; j < 4; ++j) o[j] = v[i][j] / (1.f + __expf(-v[i][j]));
            *(LAS f32x4*)(sc + 4 * q) = o; } }
    }
    __syncthreads();
    f32x4 acc[17];
#pragma unroll
    for (int r = 0; r < 17; ++r) acc[r] = (f32x4){0.f, 0.f, 0.f, 0.f};
    const int kbeg = F.wave * 128, cgp = F.lane & 15, kr = F.lane >> 4;
    const float* wp = mw + ((size_t)i * 1024 + kbeg + kr) * 6144 + cg * 64 + 4 * cgp;
    const LAS float* sp = sc + kbeg + kr;
#pragma unroll 1
    for (int hb = 0; hb < 4; ++hb) {
        f32x4 w[8];
#pragma unroll
        for (int j = 0; j < 8; ++j) w[j] = *(const f32x4*)(wp + (size_t)(4 * (8 * hb + j)) * 6144);
#pragma unroll
        for (int j = 0; j < 8; ++j)
#pragma unroll
            for (int r = 0; r < 17; ++r) acc[r] += w[j] * sp[r * 1024 + 4 * (8 * hb + j)];
    }
#pragma unroll
    for (int r = 0; r < 17; ++r) {
#pragma unroll
        for (int j = 0; j < 4; ++j) { float v = acc[r][j]; v += __shfl_xor(v, 16); v += __shfl_xor(v, 32); acc[r][j] = v; }
        if (kr == 0) *(LAS f32x4*)(part + (F.wave * 17 + r) * 64 + 4 * cgp) = acc[r];
    }
    __syncthreads();
    for (int e = F.tid; e < 17 * 64; e += 512) { const int r = e >> 6, l = e & 63; float s = mb[i * 6144 + cg * 64 + l];
#pragma unroll
        for (int w = 0; w < 8; ++w) s += part[(w * 17 + r) * 64 + l];
        MOD[((size_t)i * 17 + r) * 6144 + cg * 64 + l] = s; }
    __syncthreads();
}
__device__ __forceinline__ void p0_prologue(Frame& F, int part) {
    LAS float* scr = (LAS float*)(F.lds + F.wave * 16384);
    const int gw = F.vcu * 8 + F.wave, NGW = F.G * 8;
    constexpr int I_IN0 = 16 * 96, I_OUT0 = 16 * 32, I_UP = 16 * 176, I_DN = 44 * 32;
    if (part == 0) {
        for (int it = F.vcu; it < 32; it += F.G) mod_item(F, it);
        MK_STAMP2(20);
        const int nmodw = F.G >= 128 ? 256 : 0;
        for (int it = gw < nmodw ? I_IN0 : gw - nmodw; it < I_IN0; it += NGW - nmodw) transpose_item(F.in[8], 1024, 3072, (bf16_t*)(F.ws + WS_WIN0), SG_IN0, scr, it, F.lane);
        if (F.vcu == F.G - 1) for (int e = F.tid; e < 1024; e += 512) { const int idx = e >> 4, f = e & 15; const float inv = powf(10000.f, -(float)f / 16.f), ang = (float)idx * inv;
            ((float*)(F.ws + WS_ROPE))[e] = cosf(ang); ((float*)(F.ws + WS_ROPE))[1024 + e] = sinf(ang); }
        MK_STAMP2(21);
    } else if (part == 1) {
        for (int it = 32 + F.vcu; it < 192; it += F.G) mod_item(F, it);
    } else {
        constexpr int NITEMS = I_OUT0 + I_UP + I_DN;
        const bool wide = F.G > 160;
        const int nv = wide ? 160 * 8 + (F.G - 160) * 16 : NGW, nrep = (wide && F.vcu >= 160) ? 2 : 1;
        const int v0 = !wide ? gw : (F.vcu < 160 ? gw : 1280 + (F.vcu - 160) * 16 + F.wave);
#pragma unroll 1
        for (int k = 0;; ++k) {
            const int it = nrep == 2 ? v0 + 8 * (k & 1) + nv * (k >> 1) : v0 + nv * k;
            if (it >= NITEMS) break;
            int r = it;
            if (r < I_OUT0) { transpose_item(F.in[9], 1024, 1024, (bf16_t*)(F.ws + WS_WOUT0), SG_P8, scr, r, F.lane); continue; } r -= I_OUT0;
            if (r < I_UP) { transpose_item(F.in[25], 1024, 5632, (bf16_t*)(F.ws + WS_WUP0), SG_UP, scr, r, F.lane); continue; } r -= I_UP;
            transpose_item(F.in[28], FF, 1024, (bf16_t*)(F.ws + WS_WDN0), SG_P8, scr, r, F.lane);
        }
    }
}
__device__ __forceinline__ void weights1_pass(Frame& F, int widx, int nw, int part) {
    LAS float* scr = (LAS float*)(F.lds + F.wave * 16384);
    const int gw = widx * 8 + F.wave, NGW = nw * 8;
    constexpr int I_FOLD = 4 * 16 * 16, I_IN1 = 16 * 64, I_OUT1H = 8 * 32, I_UP = 16 * 176, I_DN = 44 * 32;
    if (part == 0) {
        for (int it = gw; it < I_IN1 + I_UP; it += NGW) {
            if (it < I_IN1) transpose_item(F.in[18], 1024, 2048, (bf16_t*)(F.ws + WS_WIN1), SG_IN1, scr, it, F.lane);
            else transpose_item(F.in[25] + (size_t)1024 * 5632, 1024, 5632, (bf16_t*)(F.ws + WS_WUP1), SG_UP, scr, it - I_IN1, F.lane);
        }
    } else {
        for (int it = gw; it < I_FOLD + I_OUT1H + I_DN; it += NGW) {
            int r = it;
            if (r < I_FOLD) { poolfold_item(F.in[20], F.in[21], F.in[19], (bf16_t*)(F.ws + WS_WOUT1), r, F.lane); continue; } r -= I_FOLD;
            if (r < I_OUT1H) { transpose_item(F.in[19], 1024, 1024, (bf16_t*)(F.ws + WS_WOUT1), SG_P8, scr, r + 8 * 32, F.lane); continue; } r -= I_OUT1H;
            transpose_item(F.in[28] + (size_t)FF * 1024, FF, 1024, (bf16_t*)(F.ws + WS_WDN1), SG_P8, scr, r, F.lane);
        }
    }
}
__device__ __forceinline__ u32x4 pack8(const f32x4 a, const f32x4 b) { u32x4 w; w.x = cvt_pk_bf16(a[0], a[1]); w.y = cvt_pk_bf16(a[2], a[3]); w.z = cvt_pk_bf16(b[0], b[1]); w.w = cvt_pk_bf16(b[2], b[3]); return w; }
__device__ __forceinline__ void norm_pass(Frame& F, const float* xl, const float* xc, int nrows, const float* gain, const float* mod  , int shoff) {
    bf16_t* H = (bf16_t*)(F.ws + WS_ACT);
    const int gw = F.vcu * 8 + F.wave, NGW = F.G * 8;
    f32x4 nx[2][4];
#define NP_LOAD(q, row_) do { const int r_ = (row_); if (r_ < nrows) { const float* xr_ = r_ < NL ? xl + (size_t)r_ * D : xc + (size_t)(r_ - NL) * D; \
        _Pragma("unroll") for (int j = 0; j < 4; ++j) nx[q][j] = *(const f32x4*)(xr_ + 512 * (j >> 1) + 8 * F.lane + 4 * (j & 1)); } } while (0)
    NP_LOAD(0, gw); NP_LOAD(1, gw + NGW);
    for (int row0 = gw; row0 < nrows; row0 += 2 * NGW) {
        f32x4 v[2][4];
#pragma unroll
        for (int q = 0; q < 2; ++q)
#pragma unroll
            for (int j = 0; j < 4; ++j) v[q][j] = nx[q][j];
        NP_LOAD(0, row0 + 2 * NGW); NP_LOAD(1, row0 + 3 * NGW);
#pragma unroll
        for (int q = 0; q < 2; ++q) { const int row = row0 + q * NGW;
            if (row < nrows) {
                const float* mrow = mod + (size_t)(row < NL ? (row >> 11) : 16) * 6144 + shoff;
                float s = 0.f;
#pragma unroll
                for (int j = 0; j < 4; ++j) s += (v[q][j].x * v[q][j].x + v[q][j].y * v[q][j].y) + (v[q][j].z * v[q][j].z + v[q][j].w * v[q][j].w);
                const float r = rsqrtf(wave_sum(s) * (1.f / D) + 1e-6f);
                f32x4 o[4];
#pragma unroll
                for (int j = 0; j < 4; ++j) { const int c = 512 * (j >> 1) + 8 * F.lane + 4 * (j & 1);
                    const f32x4 g = *(const f32x4*)(gain + c), sh = *(const f32x4*)(mrow + c), sc = *(const f32x4*)(mrow + 1024 + c);
                    o[j] = v[q][j] * r * g * (sc + 1.f) + sh; }
                *(u32x4*)(H + (size_t)row * D + 8 * F.lane) = pack8(o[0], o[1]);
                *(u32x4*)(H + (size_t)row * D + 512 + 8 * F.lane) = pack8(o[2], o[3]);
            } }
    }
#undef NP_LOAD
}
__device__ __forceinline__ void bias_pass(Frame& F, int widx, int nw, int m0, int nm) {
    int mi = widx % nm, grp = widx / nm, ngrp = (nw - mi + nm - 1) / nm;
    if (nm == 2 && nw >= 2) {
        int c1 = (nw * 32 + 60) / 120; c1 = c1 < 1 ? 1 : (c1 > nw - 1 ? nw - 1 : c1);
        if (widx < c1) { mi = 0; grp = widx; ngrp = c1; } else { mi = 1; grp = widx - c1; ngrp = nw - c1; }
    }
    const int mat = m0 + mi;
    const float* src = (const float*)(F.ws + WS_MOD) + (mat == 0 ? 0 : 17 * 6144) + (mat == 1 ? 0 : 3072);
    const bf16_t* WT = (const bf16_t*)(F.ws + (mat == 0 ? WS_WUP0 : (mat == 1 ? WS_WIN1 : WS_WUP1)));
    float* out = (float*)(F.ws + WS_BIAS + (mat == 0 ? BIAS_BU0 : (mat == 1 ? BIAS_BI1 : BIAS_BU1)));
    const int N = mat == 1 ? 2048 : 5632;
    LAS bf16_t* tb = (LAS bf16_t*)F.lds;
    __syncthreads();
    {
        f32x4 v[9];
#pragma unroll
        for (int i = 0; i < 9; ++i) { const int e = F.tid + i * 512; if (e < 17 * 256) v[i] = *(const f32x4*)(src + (size_t)(e >> 8) * 6144 + (e & 255) * 4); }
        for (int e = F.tid; e < 15 * 516; e += 512) ((LAS unsigned*)(tb + 17 * 1032))[e] = 0u;
#pragma unroll
        for (int i = 0; i < 9; ++i) { const int e = F.tid + i * 512;
            if (e < 17 * 256) { LAS unsigned* d = (LAS unsigned*)(tb + (e >> 8) * 1032 + (e & 255) * 4); d[0] = cvt_pk_bf16(v[i][0], v[i][1]); d[1] = cvt_pk_bf16(v[i][2], v[i][3]); } }
    }
    __syncthreads();
    const int r32 = F.lane & 31, hi = F.lane >> 5, kq = F.wave & 3;
    LAS float* red = (LAS float*)(F.lds + 66560);
    for (int b0 = grp * 2; b0 < N / 32; b0 += ngrp * 2) {
        const int blk = b0 + (F.wave >> 2);
        f32x16 acc;
#pragma unroll
        for (int r = 0; r < 16; ++r) acc[r] = 0.f;
        const bf16_t* ap = WT + (size_t)(blk * 32 + r32) * 1024 + hi * 8 + kq * 256;
        const LAS bf16_t* bp = tb + r32 * 1032 + hi * 8 + kq * 256;
        bf16x8 af[16];
#pragma unroll
        for (int s = 0; s < 16; ++s) af[s] = *(const bf16x8*)(ap + 16 * s);
#pragma unroll
        for (int s = 0; s < 16; ++s) acc = __builtin_amdgcn_mfma_f32_32x32x16_bf16(af[s], *(const LAS bf16x8*)(bp + 16 * s), acc, 0, 0, 0);
#pragma unroll
        for (int r = 0; r < 16; ++r) red[(F.wave * 16 + r) * 64 + F.lane] = acc[r];
        __syncthreads();
        if (kq == 0 && r32 < 17) {
#pragma unroll
            for (int r = 0; r < 16; ++r) { const LAS float* q = red + (F.wave * 16 + r) * 64 + F.lane;
                out[(size_t)r32 * N + blk * 32 + crow(r, hi)] = (q[0] + q[1024]) + (q[2048] + q[3072]); }
        }
        __syncthreads();
    }
    __syncthreads();
}
struct SsPart { float t[8]; bool ok; };
__device__ __forceinline__ void ss_fetch(SsPart& P, const float* SS, int tok, int ntok, int half) {
    P.ok = tok >= 0 && tok < ntok;
    if (P.ok) {
#pragma unroll
        for (int s = 0; s < 8; ++s) P.t[s] = SS[(size_t)(half * 8 + s) * NTOK + tok];
    }
}
__device__ __forceinline__ float ss_sum(const SsPart& P) { return P.ok ? ((P.t[0] + P.t[1]) + (P.t[2] + P.t[3])) + ((P.t[4] + P.t[5]) + (P.t[6] + P.t[7])) : -1.f; }
__device__ __forceinline__ float ss_rstd(const LAS float* pt  , int r) { const float p = pt[r] + pt[256 + r]; return p < 0.f ? 0.f : rsqrtf(p * (1.f / 1024.f) + 1e-6f); }
typedef f32x4 Acc[2][2][4][2];
__device__ __forceinline__ u32x2 pack4(const f32x4 a) { u32x2 w; w.x = cvt_pk_bf16(a[0], a[1]); w.y = cvt_pk_bf16(a[2], a[3]); return w; }

struct EpiIn0 {
    static constexpr bool PF = false;
    unsigned char* ws; const float* qg; const float* kg;
    __device__ __forceinline__ void operator()(Acc& acc, const pg8::Unit& u, const pg8::Unit& nx, bool has_next, int ui, int wr, int wc, int fr_, int fq_) const {
        int fr = fr_, fq = fq_; asm volatile("" : "+v"(fr), "+v"(fq));
        const int row0 = u.pm * 256 + wr * 64 + fr, pn = u.pn;
        if (pn < 2 || pn >= 10) {
            bf16_t* O = (bf16_t*)(ws + (pn < 2 ? WS_BG : WS_V)); const int colt = (pn < 2 ? pn : pn - 10) * 256 + wc * 32 + 8 * fq;
#pragma unroll
            for (int ai = 0; ai < 2; ++ai)
#pragma unroll
                for (int m = 0; m < 4; ++m)
#pragma unroll
                    for (int bj = 0; bj < 2; ++bj) *(u32x4*)(O + (size_t)(row0 + ai * 128 + m * 16) * 512 + colt + bj * 128) = pack8(acc[ai][bj][m][0], acc[ai][bj][m][1]);
        } else if (pn < 6) {
            bf16_t* O = (bf16_t*)(ws + WS_U); const int colt = (pn - 2) * 128 + wc * 32 + 8 * fq;
#pragma unroll
            for (int ai = 0; ai < 2; ++ai)
#pragma unroll
                for (int m = 0; m < 4; ++m) *(u32x4*)(O + (size_t)(row0 + ai * 128 + m * 16) * 512 + colt) = pack8(acc[ai][0][m][0] * acc[ai][1][m][0], acc[ai][0][m][1] * acc[ai][1][m][1]);
        } else {
            const int ch = (pn - 6) * 4 + wc; const bool isk = ch >= 8;
            bf16_t* O = (bf16_t*)(ws + (isk ? WS_K : WS_Q)) + 64 * (ch & 7);
            const float* gp = isk ? kg : qg; const float gs = isk ? 1.f : 0.125f * 1.4426950408889634f;
            const int ax = fq >> 1, dq = 32 * ax + 8 * (fq & 1);
            f32x4 gv[2][2];
#pragma unroll
            for (int bj = 0; bj < 2; ++bj)
#pragma unroll
                for (int n = 0; n < 2; ++n) gv[bj][n] = *(const f32x4*)(gp + dq + 16 * bj + 4 * n) * gs;
            const float* ct = (const float*)(ws + WS_ROPE);
#pragma unroll
            for (int ai = 0; ai < 2; ++ai)
#pragma unroll
                for (int m = 0; m < 4; ++m) {
                    const int row = row0 + ai * 128 + m * 16;
                    float ss = 0.f;
#pragma unroll
                    for (int bj = 0; bj < 2; ++bj)
#pragma unroll
                        for (int n = 0; n < 2; ++n) { const f32x4 x = acc[ai][bj][m][n]; ss += (x[0] * x[0] + x[1] * x[1]) + (x[2] * x[2] + x[3] * x[3]); }
                    ss += __shfl_xor(ss, 16); ss += __shfl_xor(ss, 32);
                    const float ri = rsqrtf(ss * (1.f / 64.f) + 1e-6f);
                    const bool rot = row < NL; const int pos = row & 2047; const int idx = ax ? (pos & 63) : (pos >> 6);
                    f32x4 y1[2], y2[2];
#pragma unroll
                    for (int n = 0; n < 2; ++n) {
                        f32x4 x1 = acc[ai][0][m][n] * ri * gv[0][n], x2 = acc[ai][1][m][n] * ri * gv[1][n];
                        if (rot) { const f32x4 cs = *(const f32x4*)(ct + idx * 16 + 8 * (fq & 1) + 4 * n), sn = *(const f32x4*)(ct + 1024 + idx * 16 + 8 * (fq & 1) + 4 * n);
                            const f32x4 o1 = x1 * cs - x2 * sn, o2 = x1 * sn + x2 * cs; x1 = o1; x2 = o2; }
                        y1[n] = x1; y2[n] = x2;
                    }
                    *(u32x4*)(O + (size_t)row * 512 + dq) = pack8(y1[0], y1[1]);
                    *(u32x4*)(O + (size_t)row * 512 + dq + 16) = pack8(y2[0], y2[1]);
                }
        }
    }
};
struct EpiRes {
    static constexpr bool PF = false;
    __device__ __forceinline__ const char* pf_base(const pg8::Unit& u) const { const int trow = u.pm * 256; return (const char*)((trow < NL ? xin_l + (size_t)trow * D : xin_c + (size_t)(trow - NL) * D) + u.pn * 256); }
    const float* xin_l; const float* xin_c; float* xout_l; float* xout_c; const float* mod; int goff;
    bf16_t* An; const float* ngain; const float* nmod; int scoff; float* SS;
    __device__ __forceinline__ void operator()(Acc& acc, const pg8::Unit& u, const pg8::Unit& nx, bool has_next, int ui, int wr, int wc, int fr_, int fq_) const {
        int fr = fr_, fq = fq_; asm volatile("" : "+v"(fr), "+v"(fq));
        const int trow = u.pm * 256; const bool lat = trow < NL; const int brow = lat ? (trow >> 11) : 16;
        const float* xin = lat ? xin_l + (size_t)trow * D : xin_c + (size_t)(trow - NL) * D;
        float* xout = lat ? xout_l + (size_t)trow * D : xout_c + (size_t)(trow - NL) * D;
        const float* gp = mod + (size_t)brow * 6144 + goff;
        const int col0 = u.pn * 256 + wc * 32 + 8 * fq;
        f32x4 gv[2][2], gs[2][2];
#pragma unroll
        for (int bj = 0; bj < 2; ++bj)
#pragma unroll
            for (int n = 0; n < 2; ++n) { gv[bj][n] = *(const f32x4*)(gp + col0 + bj * 128 + n * 4);
                if (An) gs[bj][n] = *(const f32x4*)(ngain + col0 + bj * 128 + n * 4) * (*(const f32x4*)(nmod + (size_t)brow * 6144 + scoff + col0 + bj * 128 + n * 4) + 1.f); }
#pragma unroll
        for (int ai = 0; ai < 2; ++ai)
#pragma unroll
            for (int m = 0; m < 4; ++m) { const size_t off = (size_t)(ai * 128 + wr * 64 + m * 16 + fr) * D + col0;
#pragma unroll
                for (int bj = 0; bj < 2; ++bj)
#pragma unroll
                    for (int n = 0; n < 2; ++n) { const f32x4 xi = *(const f32x4*)(xin + off + bj * 128 + n * 4); acc[ai][bj][m][n] = xi + gv[bj][n] * acc[ai][bj][m][n]; }
                if (m == 3) { asm volatile("" : "+v"(acc[ai][0][0][0]), "+v"(acc[ai][0][0][1]), "+v"(acc[ai][1][0][0]), "+v"(acc[ai][1][0][1]), "+v"(acc[ai][0][1][0]), "+v"(acc[ai][0][1][1]), "+v"(acc[ai][1][1][0]), "+v"(acc[ai][1][1][1]), "+v"(acc[ai][0][2][0]), "+v"(acc[ai][0][2][1]), "+v"(acc[ai][1][2][0]), "+v"(acc[ai][1][2][1]), "+v"(acc[ai][0][3][0]), "+v"(acc[ai][0][3][1]), "+v"(acc[ai][1][3][0]), "+v"(acc[ai][1][3][1]) :: "memory"); } }
#pragma unroll
        for (int ai = 0; ai < 2; ++ai)
        { float ssr[4] = {0.f, 0.f, 0.f, 0.f};
#pragma unroll
            for (int m = 0; m < 4; ++m) { const int rl = ai * 128 + wr * 64 + m * 16 + fr; const size_t off = (size_t)rl * D + col0;
                float ss = 0.f;
#pragma unroll
                for (int bj = 0; bj < 2; ++bj)
                { const f32x4 x0 = acc[ai][bj][m][0], x1 = acc[ai][bj][m][1]; *(f32x4*)(xout + off + bj * 128) = x0; *(f32x4*)(xout + off + bj * 128 + 4) = x1;
                  if (An) { ss += ((x0[0] * x0[0] + x0[1] * x0[1]) + (x0[2] * x0[2] + x0[3] * x0[3])) + ((x1[0] * x1[0] + x1[1] * x1[1]) + (x1[2] * x1[2] + x1[3] * x1[3]));
                            *(u32x4*)(An + (size_t)(trow + rl) * D + col0 + bj * 128) = pack8(x0 * gs[bj][0], x1 * gs[bj][1]); } }
                if (An) { ss += __shfl_xor(ss, 16); ss += __shfl_xor(ss, 32); ssr[m] = ss; } }
            if (An) { const float sel = fq == 0 ? ssr[0] : fq == 1 ? ssr[1] : fq == 2 ? ssr[2] : ssr[3];
                SS[(size_t)(u.pn * 4 + wc) * NTOK + trow + ai * 128 + wr * 64 + 16 * fq + fr] = sel; } }
    }
};
template <int CTRL> __device__ __forceinline__ float dpp_mov(float old, float src) { return __int_as_float(__builtin_amdgcn_update_dpp(__float_as_int(old), __float_as_int(src), CTRL, 0xf, 0xf, false)); }
struct EpiUp {
    static constexpr bool PF = false;
    bf16_t* HACT; const float* cw; const float* cb; int ntok; LAS float* edge;
    const float* SS; const float* bias;
    int tokbase, tokmin;
    __device__ __forceinline__ void operator()(Acc& acc, const pg8::Unit& u, const pg8::Unit& nx, bool has_next, int ui, int wr, int wc, int fr_, int fq_) const {
        int fr = fr_, fq = fq_; asm volatile("" : "+v"(fr), "+v"(fq));
        const int tok0 = tokbase + u.pm * 254 - 1;
        LAS float* ptab = edge + 1280;
        const int tid_ = (wr * 4 + wc) * 64 + fq * 16 + fr, prow = tid_ & 255, phalf = tid_ >> 8;
        const int tlo = tok0 < 0 ? 0 : tok0, thi = tok0 + 255 >= ntok ? ntok - 1 : tok0 + 255;
        const int blo = tlo < NL ? (tlo >> 11) : 16, bhi = thi < NL ? (thi >> 11) : 16;
        const int split = (blo + 1) * 2048;
        const int colh = u.pn * 128 + wc * 32 + 8 * fq;
        f32x4 blv[2][2];
#pragma unroll
        for (int bj = 0; bj < 2; ++bj)
#pragma unroll
            for (int n = 0; n < 2; ++n) blv[bj][n] = *(const f32x4*)(bias + (size_t)blo * 5632 + u.pn * 256 + bj * 128 + wc * 32 + 16 * n + 4 * fq);
        if (ui == 0) {
            SsPart P0; ss_fetch(P0, SS, tok0 + prow, ntok, phalf); ptab[phalf * 256 + prow] = ss_sum(P0);
            asm volatile("s_waitcnt lgkmcnt(0)" ::: "memory"); __builtin_amdgcn_s_barrier(); asm volatile("" ::: "memory");
        }
        SsPart PN; PN.ok = false;
        if (has_next) ss_fetch(PN, SS, tokbase + nx.pm * 254 - 1 + prow, ntok, phalf);
        {
            const LAS float* pt = ptab + (ui & 1) * 512;
            float rs8[2][4];
#pragma unroll
            for (int ai = 0; ai < 2; ++ai)
#pragma unroll
                for (int m = 0; m < 4; ++m) rs8[ai][m] = ss_rstd(pt, 128 * ai + 64 * wr + 16 * m + fr);
#pragma unroll
            for (int bj = 0; bj < 2; ++bj)
#pragma unroll
                for (int n = 0; n < 2; ++n) {
                    const int tcol = u.pn * 256 + bj * 128 + wc * 32 + 16 * n + 4 * fq;
                    const f32x4 bl = blv[bj][n]; f32x4 bh = bl;
                    if (blo != bhi) bh = *(const f32x4*)(bias + (size_t)bhi * 5632 + tcol);
#pragma unroll
                    for (int ai = 0; ai < 2; ++ai)
#pragma unroll
                        for (int m = 0; m < 4; ++m) { const int r = 128 * ai + 64 * wr + 16 * m + fr; f32x4 bsel = bl; if (blo != bhi) bsel = (tok0 + r) >= split ? bh : bl;
                            acc[ai][bj][m][n] = acc[ai][bj][m][n] * rs8[ai][m] + bsel; }
                }
        }
        f32x4 cwa[4];
        cwa[0] = *(const f32x4*)(cw + colh); cwa[1] = *(const f32x4*)(cw + FF + colh); cwa[2] = *(const f32x4*)(cw + 2 * FF + colh); cwa[3] = *(const f32x4*)(cb + colh);
#pragma unroll
        for (int ai = 0; ai < 2; ++ai) {
            if (fr == 0) { *(f32x4*)(edge + (((wr * 4 + wc) * 2 + ai) * 2 + 0) * 32 + 8 * fq) = acc[ai][0][0][0]; *(f32x4*)(edge + (((wr * 4 + wc) * 2 + ai) * 2 + 0) * 32 + 8 * fq + 4) = acc[ai][0][0][1]; }
            if (fr == 15) { *(f32x4*)(edge + (((wr * 4 + wc) * 2 + ai) * 2 + 1) * 32 + 8 * fq) = acc[ai][0][3][0]; *(f32x4*)(edge + (((wr * 4 + wc) * 2 + ai) * 2 + 1) * 32 + 8 * fq + 4) = acc[ai][0][3][1]; }
        }
        asm volatile("s_waitcnt lgkmcnt(0)" ::: "memory"); __builtin_amdgcn_s_barrier(); asm volatile("" ::: "memory");
        if (has_next) ptab[((ui + 1) & 1) * 512 + phalf * 256 + prow] = ss_sum(PN);
        const int lo_ = tok0 < 1 ? 1 : tok0;
        const bool anyb = (tok0 + 256 >= NL) || (tok0 < 1) || (((lo_ - 1) >> 11) != ((tok0 + 256) >> 11));
        u32x2 stash[2][4];
#pragma unroll
        for (int n = 0; n < 2; ++n) {
            const f32x4 w0 = n == 0 ? cwa[0] : *(const f32x4*)(cw + colh + 4), w1 = n == 0 ? cwa[1] : *(const f32x4*)(cw + FF + colh + 4), w2 = n == 0 ? cwa[2] : *(const f32x4*)(cw + 2 * FF + colh + 4),
                        bb = n == 0 ? cwa[3] : *(const f32x4*)(cb + colh + 4);
#pragma unroll
            for (int ai = 0; ai < 2; ++ai) {
                const int seg = 2 * ai + wr;
                const int ps = seg > 0 ? seg - 1 : 0, ns = seg < 3 ? seg + 1 : 3;
                const f32x4 pe = *(const LAS f32x4*)(edge + ((((ps & 1) * 4 + wc) * 2 + (ps >> 1)) * 2 + 1) * 32 + 8 * fq + 4 * n);
                const f32x4 ne = *(const LAS f32x4*)(edge + ((((ns & 1) * 4 + wc) * 2 + (ns >> 1)) * 2 + 0) * 32 + 8 * fq + 4 * n);
#pragma unroll
                for (int m = 0; m < 4; ++m) {
                    const int r = 64 * seg + 16 * m + fr, tok = tok0 + r;
                    const bool first = tok < NL ? (tok & 2047) == 0 : (tok & 255) == 0;
                    const int tn = tok + 1; const bool last = (tn >= ntok) || (tn < NL ? (tn & 2047) == 0 : (tn & 255) == 0);
                    f32x4 pv, nv;
#pragma unroll
                    for (int j = 0; j < 4; ++j) {
                        const float cur = acc[ai][0][m][n][j];
                        const float pold = m > 0 ? dpp_mov<0x121>(0.f, acc[ai][0][m > 0 ? m - 1 : 0][n][j]) : pe[j];
                        const float nold = m < 3 ? dpp_mov<0x12F>(0.f, acc[ai][0][m < 3 ? m + 1 : 3][n][j]) : ne[j];
                        pv[j] = dpp_mov<0x111>(pold, cur);
                        nv[j] = dpp_mov<0x101>(nold, cur);
                    }
                    if (anyb) { if (first) pv = (f32x4){0.f, 0.f, 0.f, 0.f}; if (last) nv = (f32x4){0.f, 0.f, 0.f, 0.f}; }
                    const f32x4 a = pv * w0 + acc[ai][0][m][n] * w1 + nv * w2 + bb;
                    f32x4 hv;
#pragma unroll
                    for (int j = 0; j < 4; ++j) hv[j] = fast_silu(a[j]) * acc[ai][1][m][n][j];
                    if (n == 0) stash[ai][m] = pack4(hv);
                    else { const u32x2 hi2 = pack4(hv); const u32x4 w = {stash[ai][m].x, stash[ai][m].y, hi2.x, hi2.y};
                           if (r >= 1 && r <= 254 && tok < ntok && tok >= tokmin) *(u32x4*)(HACT + (size_t)tok * FF + colh) = w; }
                }
            }
        }
    }
};
struct EpiIn1 {
    static constexpr bool PF = false;
    unsigned char* ws; const float* decf; const float* decb; const float* SS; const float* bias; LAS float* tab;
    __device__ __forceinline__ void operator()(Acc& acc, const pg8::Unit& u, const pg8::Unit& nx, bool has_next, int ui, int wr, int wc, int fr_, int fq_) const {
        int fr = fr_, fq = fq_; asm volatile("" : "+v"(fr), "+v"(fq));
        const int row0 = u.pm * 256 + wr * 64 + fr, pn = u.pn;
        {
            LAS float* ptab = tab + 1280;
            const int tid_ = (wr * 4 + wc) * 64 + fq * 16 + fr, prow = tid_ & 255, phalf = tid_ >> 8;
            const float* bp = bias + (size_t)(u.pm < 128 ? (u.pm >> 3) : 16) * 2048 + pn * 256 + wc * 32 + 4 * fq;
            f32x4 bvv[2][2];
#pragma unroll
            for (int bj = 0; bj < 2; ++bj)
#pragma unroll
                for (int n = 0; n < 2; ++n) bvv[bj][n] = *(const f32x4*)(bp + bj * 128 + n * 16);
            if (ui == 0) {
                SsPart P0; ss_fetch(P0, SS, u.pm * 256 + prow, NTOK, phalf); ptab[phalf * 256 + prow] = ss_sum(P0);
                asm volatile("s_waitcnt lgkmcnt(0)" ::: "memory"); __builtin_amdgcn_s_barrier(); asm volatile("" ::: "memory");
            }
            SsPart PN; PN.ok = false;
            if (has_next) ss_fetch(PN, SS, nx.pm * 256 + prow, NTOK, phalf);
            const LAS float* pt = ptab + (ui & 1) * 512;
            float rs8[2][4];
#pragma unroll
            for (int ai = 0; ai < 2; ++ai)
#pragma unroll
                for (int m = 0; m < 4; ++m) rs8[ai][m] = ss_rstd(pt, ai * 128 + wr * 64 + m * 16 + fr);
#pragma unroll
            for (int bj = 0; bj < 2; ++bj)
#pragma unroll
                for (int n = 0; n < 2; ++n) { const f32x4 bv = bvv[bj][n];
#pragma unroll
                    for (int ai = 0; ai < 2; ++ai)
#pragma unroll
                        for (int m = 0; m < 4; ++m) acc[ai][bj][m][n] = acc[ai][bj][m][n] * rs8[ai][m] + bv; }
            if (has_next) ptab[((ui + 1) & 1) * 512 + phalf * 256 + prow] = ss_sum(PN);
        }
        if (pn == 2 || pn == 3) {
            const bool isk = pn == 3; const int h = wc;
            const float lf2 = -__expf(decf[h]) * 1.4426950408889634f, lb2 = -__expf(decb[h]) * 1.4426950408889634f;
            const size_t hb = (size_t)h * (isk ? NTOK : NL) * 64;
            bf16_t* OF = (bf16_t*)(ws + (isk ? WS_KF : WS_QF)) + hb; bf16_t* OB = (bf16_t*)(ws + (isk ? WS_KB : WS_QB)) + hb;
            const float* ct = (const float*)(ws + WS_ROPE);
#pragma unroll
            for (int ai = 0; ai < 2; ++ai)
#pragma unroll
                for (int m = 0; m < 4; ++m) {
                    const int row = row0 + ai * 128 + m * 16; const bool rot = row < NL; const int pos = row & 2047; const float p = (float)(row & 127);
                    const float sf = isk ? __builtin_amdgcn_exp2f(-lf2 * p) : 0.125f * __builtin_amdgcn_exp2f(lf2 * p);
                    const float sb = isk ? __builtin_amdgcn_exp2f(lb2 * (p - 127.f)) : 0.125f * __builtin_amdgcn_exp2f(lb2 * (127.f - p));
                    const int ax = fq >> 1, dq = 32 * ax + 8 * (fq & 1), idx = ax ? (pos & 63) : (pos >> 6);
                    f32x4 y1[2], y2[2];
#pragma unroll
                    for (int n = 0; n < 2; ++n) {
                        f32x4 x1 = acc[ai][0][m][n], x2 = acc[ai][1][m][n];
                        if (rot) { const f32x4 cs = *(const f32x4*)(ct + idx * 16 + 8 * (fq & 1) + 4 * n), sn = *(const f32x4*)(ct + 1024 + idx * 16 + 8 * (fq & 1) + 4 * n);
                            const f32x4 o1 = x1 * cs - x2 * sn, o2 = x1 * sn + x2 * cs; x1 = o1; x2 = o2; }
                        y1[n] = x1; y2[n] = x2;
                    }
                    *(u32x4*)(OF + (size_t)row * 64 + dq) = pack8(y1[0] * sf, y1[1] * sf); *(u32x4*)(OF + (size_t)row * 64 + dq + 16) = pack8(y2[0] * sf, y2[1] * sf);
                    *(u32x4*)(OB + (size_t)row * 64 + dq) = pack8(y1[0] * sb, y1[1] * sb); *(u32x4*)(OB + (size_t)row * 64 + dq + 16) = pack8(y2[0] * sb, y2[1] * sb);
                }
        } else {
            const bool isg = pn >= 6;
            if (pn < 2) {
                bf16_t* O = (bf16_t*)(ws + WS_PV); const int colt = pn * 256 + wc * 32 + 8 * fq;
#pragma unroll
                for (int ai = 0; ai < 2; ++ai)
#pragma unroll
                    for (int m = 0; m < 4; ++m)
#pragma unroll
                        for (int bj = 0; bj < 2; ++bj) *(u32x4*)(O + (size_t)(row0 + ai * 128 + m * 16) * 512 + colt + bj * 128) = pack8(acc[ai][bj][m][0], acc[ai][bj][m][1]);
            } else {
                bf16_t* O = (bf16_t*)(ws + (isg ? WS_G1 : WS_V1)); const size_t nr = isg ? NL : NTOK; const int hp = 2 * (pn - (isg ? 6 : 4));
#pragma unroll
                for (int ai = 0; ai < 2; ++ai)
#pragma unroll
                    for (int m = 0; m < 4; ++m)
#pragma unroll
                        for (int bj = 0; bj < 2; ++bj) { f32x4 a = acc[ai][bj][m][0], b = acc[ai][bj][m][1];
                            if (isg) {
#pragma unroll
                                for (int j = 0; j < 4; ++j) { a[j] = fast_silu(a[j]); b[j] = fast_silu(b[j]); } }
                            *(u32x4*)(O + ((size_t)(hp + bj) * nr + row0 + ai * 128 + m * 16) * 128 + wc * 32 + 8 * fq) = pack8(a, b); }
            }
        }
    }
};
struct OrderIn1 {
    pg8::StaticOrder so; int G, c;
    __device__ void init(int G_, int c_) { so.init(128, 8, G_, c_); G = G_; c = c_; }
    __device__ bool next(int i, pg8::Unit& u) const {
        const int L = i * G + c;
        if (L < 1024) return so.next(i, u);
        const int e = L - 1024; if (e >= 48) return false;
        u.pm = 128 + e / 3; u.pn = 3 + e % 3; return true;
    }
};
}
namespace mk {
#define MFMA32(a, b, c) __builtin_amdgcn_mfma_f32_32x32x16_bf16((a), (b), (c), 0, 0, 0)
__device__ __forceinline__ bf16x8 as_bf16x8(u32x4 v) { return __builtin_bit_cast(bf16x8, v); }

struct AttnCtx { const bf16_t* Q; const bf16_t* K; const bf16_t* V; bf16_t* A2; const float* subln; float lam, negMb; };
__device__ __forceinline__ void attn_unit(Frame& F, const AttnCtx& C, int h, int qrow0, int ka, int nta, int kb, int ntb) {
    const int lane = F.lane, w = F.wave, r32 = lane & 31, hi = lane >> 5, mp = w >> 2, qb = w & 3;
    const unsigned lds0 = (unsigned)(uintptr_t)F.lds;
    const LAS char* L = (const LAS char*)F.lds;
    LAS float* wsf = (LAS float*)(F.lds + 114688 + 256 * w);
    const bf16_t* qp = C.Q + (size_t)(qrow0 + 32 * qb + r32) * 512 + h * 128 + mp * 64 + hi * 8;
    bf16x8 qr[4];
#pragma unroll
    for (int d0 = 0; d0 < 4; ++d0) qr[d0] = *(const bf16x8*)(qp + d0 * 16);
    const bf16_t* ksrc = C.K + (size_t)lane * 512 + h * 128 + w * 8;
    const int pv0 = 2 * w, pv1 = 2 * w + 1;
    const bf16_t* vsrc0 = C.V + (size_t)(16 * (pv0 & 3) + (lane >> 2)) * 512 + h * 128 + (pv0 >> 2) * 32 + (lane & 3) * 8;
    const bf16_t* vsrc1 = C.V + (size_t)(16 * (pv1 & 3) + (lane >> 2)) * 512 + h * 128 + (pv1 >> 2) * 32 + (lane & 3) * 8;
    const int NT = nta + ntb;
#define AT_ROW(t_) ((size_t)((t_) < nta ? ka + 64 * (t_) : kb + 64 * ((t_) - nta)) * 512)
#define AT_ISSUE_K(t, slot) do { const size_t ko_ = AT_ROW(t); const unsigned sb_ = lds0 + (unsigned)(slot) * 16384u; \
        glds16(ksrc + ko_, (unsigned)__builtin_amdgcn_readfirstlane(sb_ + w * 1024)); glds16(ksrc + ko_ + 64, (unsigned)__builtin_amdgcn_readfirstlane(sb_ + 8192 + w * 1024)); } while (0)
#define AT_ISSUE_V(t, slot) do { const size_t ko_ = AT_ROW(t); const unsigned sb_ = lds0 + 65536u + (unsigned)(slot) * 16384u; \
        glds16(vsrc0 + ko_, (unsigned)__builtin_amdgcn_readfirstlane(sb_ + pv0 * 1024)); glds16(vsrc1 + ko_, (unsigned)__builtin_amdgcn_readfirstlane(sb_ + pv1 * 1024)); } while (0)
#define SBAR() __builtin_amdgcn_sched_barrier(0)
    AT_ISSUE_K(0, 0); AT_ISSUE_K(1, 1); if (2 < NT) AT_ISSUE_K(2, 2); AT_ISSUE_V(0, 0);
    f32x16 o[4];
#pragma unroll
    for (int d0 = 0; d0 < 4; ++d0)
#pragma unroll
        for (int r = 0; r < 16; ++r) o[d0][r] = 0.f;
    float lsum = 0.f;
    f32x16 e0, e1;
    const LAS char* kb0 = L + mp * 8192 + hi * 1024 + r32 * 16;
    const LAS char* vb0 = L + 65536 + ((lane >> 4) & 1) * 32 + (lane & 3) * 8 + (4 * hi + ((lane & 15) >> 2)) * 64;
    WAIT_BAR(4);
    if (3 < NT) AT_ISSUE_K(3, 3);
    if (1 < NT) AT_ISSUE_V(1, 1);
    bf16x8 kf[8];
    {
#pragma unroll
        for (int r = 0; r < 16; ++r) { e0[r] = 0.f; e1[r] = 0.f; }
#pragma unroll
        for (int d0 = 0; d0 < 4; ++d0) { e0 = MFMA32(*(const LAS bf16x8*)(kb0 + d0 * 2048), qr[d0], e0); e1 = MFMA32(*(const LAS bf16x8*)(kb0 + d0 * 2048 + 512), qr[d0], e1); }
#pragma unroll
        for (int d0 = 0; d0 < 4; ++d0) { kf[2 * d0] = *(const LAS bf16x8*)(kb0 + 16384 + d0 * 2048); kf[2 * d0 + 1] = *(const LAS bf16x8*)(kb0 + 16384 + d0 * 2048 + 512); }
#pragma unroll
        for (int r = 0; r < 16; ++r) { e0[r] = __builtin_amdgcn_exp2f(e0[r]); e1[r] = __builtin_amdgcn_exp2f(e1[r]); }
    }
    int ks_ = 1, vs_ = 0;
    for (int t = 1; t < NT; ++t) {
        if (t + 2 < NT) { WAIT_BAR(4); } else { WAIT_BAR(2); }
        { int kn = (ks_ + 3) & 3; int vn = vs_ + 2; if (vn >= 3) vn -= 3;
          if (t + 3 < NT) AT_ISSUE_K(t + 3, kn);
          if (t + 1 < NT) AT_ISSUE_V(t + 1, vn); }
        const int kn1 = (ks_ + 1) & 3;
        const LAS char* kbn = kb0 + kn1 * 16384;
        const LAS char* vbp = vb0 + vs_ * 16384;
        const bool more = t + 1 < NT;
        f32x16 n0, n1;
#pragma unroll
        for (int r = 0; r < 16; ++r) { n0[r] = 0.f; n1[r] = 0.f; }
        u32x4 pw[4];
#define AT_VOFF(J) ((((J) & 3) * 4096) + (((J) >> 2) * 1024))
        s16x4 vl0 = tr_read(vbp + AT_VOFF(0)), vh0 = tr_read(vbp + AT_VOFF(0) + 512);
        s16x4 vl1 = tr_read(vbp + AT_VOFF(1)), vh1 = tr_read(vbp + AT_VOFF(1) + 512);
        s16x4 vl2, vh2;
        SBAR();
#define AT_A(ACC, KF, QD, EV, EB, PWK, PWI) do { ACC = MFMA32(KF, qr[QD], ACC); \
        lsum += (EV[EB] + EV[EB + 1]) + (EV[EB + 2] + EV[EB + 3]); pw[PWK][PWI] = cvt_pk_bf16(EV[EB], EV[EB + 1]); pw[PWK][PWI + 1] = cvt_pk_bf16(EV[EB + 2], EV[EB + 3]); SBAR(); } while (0)
        AT_A(n0, kf[0], 0, e0, 0, 0, 0);  AT_A(n1, kf[1], 0, e0, 4, 0, 2);
        AT_A(n0, kf[2], 1, e0, 8, 1, 0);  AT_A(n1, kf[3], 1, e0, 12, 1, 2);
        AT_A(n0, kf[4], 2, e1, 0, 2, 0);  AT_A(n1, kf[5], 2, e1, 4, 2, 2);
        AT_A(n0, kf[6], 3, e1, 8, 3, 0);  AT_A(n1, kf[7], 3, e1, 12, 3, 2);
#undef AT_A
#define AT_B(J, CL, CH, NL_, NH_, NV, NB, KLOAD) do { if ((J) + 2 < 16) { NL_ = tr_read(vbp + AT_VOFF((J) + 2)); NH_ = tr_read(vbp + AT_VOFF((J) + 2) + 512); } KLOAD; \
        o[(J) & 3] = MFMA32(as_bf16x8(pw[(J) >> 2]), cat8(CL, CH), o[(J) & 3]); NV[NB] = __builtin_amdgcn_exp2f(NV[NB]); NV[NB + 1] = __builtin_amdgcn_exp2f(NV[NB + 1]); SBAR(); } while (0)
#define AT_KL(I) do { if (more) kf[I] = *(const LAS bf16x8*)(kbn + ((I) >> 1) * 2048 + ((I) & 1) * 512); } while (0)
        AT_B(0, vl0, vh0, vl2, vh2, n0, 0, (void)0);    AT_B(1, vl1, vh1, vl0, vh0, n0, 2, (void)0);    AT_B(2, vl2, vh2, vl1, vh1, n0, 4, (void)0);
        AT_B(3, vl0, vh0, vl2, vh2, n0, 6, (void)0);    AT_B(4, vl1, vh1, vl0, vh0, n0, 8, (void)0);    AT_B(5, vl2, vh2, vl1, vh1, n0, 10, (void)0);
        AT_B(6, vl0, vh0, vl2, vh2, n0, 12, (void)0);   AT_B(7, vl1, vh1, vl0, vh0, n0, 14, (void)0);   AT_B(8, vl2, vh2, vl1, vh1, n1, 0, AT_KL(0));
        AT_B(9, vl0, vh0, vl2, vh2, n1, 2, AT_KL(1));   AT_B(10, vl1, vh1, vl0, vh0, n1, 4, AT_KL(2));  AT_B(11, vl2, vh2, vl1, vh1, n1, 6, AT_KL(3));
        AT_B(12, vl0, vh0, vl2, vh2, n1, 8, AT_KL(4));  AT_B(13, vl1, vh1, vl0, vh0, n1, 10, AT_KL(5)); AT_B(14, vl2, vh2, vl1, vh1, n1, 12, AT_KL(6));
        AT_B(15, vl0, vh0, vl2, vh2, n1, 14, AT_KL(7));
#undef AT_B
#undef AT_KL
#undef AT_VOFF
        e0 = n0; e1 = n1;
        ks_ = (ks_ + 1) & 3;
        vs_ = vs_ + 1; if (vs_ >= 3) vs_ = 0;
    }
    WAIT_BAR(0);
    {
        const LAS char* vbp = vb0 + vs_ * 16384;
        u32x4 pw[4];
#pragma unroll
        for (int i = 0; i < 4; ++i) { pw[0][i] = cvt_pk_bf16(e0[2 * i], e0[2 * i + 1]); pw[1][i] = cvt_pk_bf16(e0[8 + 2 * i], e0[9 + 2 * i]); pw[2][i] = cvt_pk_bf16(e1[2 * i], e1[2 * i + 1]); pw[3][i] = cvt_pk_bf16(e1[8 + 2 * i], e1[9 + 2 * i]); }
#pragma unroll
        for (int r = 0; r < 16; ++r) lsum += e0[r] + e1[r];
#pragma unroll
        for (int d0 = 0; d0 < 4; ++d0)
#pragma unroll
            for (int ks = 0; ks < 4; ++ks) {
                const s16x4 lo = tr_read(vbp + d0 * 4096 + ks * 1024), hh = tr_read(vbp + d0 * 4096 + ks * 1024 + 512);
                o[d0] = MFMA32(as_bf16x8(pw[ks]), cat8(lo, hh), o[d0]);
            }
    }
#undef AT_ISSUE_K
#undef AT_ISSUE_V
#undef AT_ROW
#undef SBAR
    lsum += __shfl_xor(lsum, 32);
    if (hi == 0) wsf[r32] = (mp ? C.lam : 1.f) / lsum;
    asm volatile("s_waitcnt lgkmcnt(0)" ::: "memory");
    float rli[16];
#pragma unroll
    for (int r = 0; r < 16; ++r) rli[r] = wsf[crow(r, hi)];
    asm volatile("s_waitcnt lgkmcnt(0)" ::: "memory"); __builtin_amdgcn_s_barrier(); asm volatile("" ::: "memory");
    LAS float* CB = (LAS float*)F.lds;
    if (mp == 1) {
#pragma unroll
        for (int d0 = 0; d0 < 4; ++d0)
#pragma unroll
            for (int r = 0; r < 16; ++r) CB[(32 * qb + crow(r, hi)) * 132 + 32 * d0 + r32] = o[d0][r] * rli[r];
    }
    asm volatile("s_waitcnt lgkmcnt(0)" ::: "memory"); __builtin_amdgcn_s_barrier(); asm volatile("" ::: "memory");
    if (mp == 0) {
#pragma unroll
        for (int d0 = 0; d0 < 4; ++d0)
#pragma unroll
            for (int r = 0; r < 16; ++r) { LAS float* p = CB + (32 * qb + crow(r, hi)) * 132 + 32 * d0 + r32; *p = o[d0][r] * rli[r] - *p; }
        asm volatile("s_waitcnt lgkmcnt(0)" ::: "memory");
        const int row = lane >> 1, half = lane & 1;
        const LAS float* rp = CB + (32 * qb + row) * 132 + 64 * half;
        f32x4 v[16]; float ss = 0.f;
#pragma unroll
        for (int i = 0; i < 16; ++i) { v[i] = *(const LAS f32x4*)(rp + 4 * i); ss += (v[i][0] * v[i][0] + v[i][1] * v[i][1]) + (v[i][2] * v[i][2] + v[i][3] * v[i][3]); }
        ss += __shfl_xor(ss, 1);
        const float ri = rsqrtf(ss * (1.f / 128.f) + 1e-6f) * 0.8f;
        bf16_t* op = C.A2 + (size_t)(qrow0 + 32 * qb + row) * 1024 + 512 + h * 128 + 64 * half;
#pragma unroll
        for (int i = 0; i < 8; ++i) {
            const f32x4 g0 = *(const f32x4*)(C.subln + 64 * half + 8 * i), g1 = *(const f32x4*)(C.subln + 64 * half + 8 * i + 4);
            *(u32x4*)(op + 8 * i) = pack8(v[2 * i] * ri * g0, v[2 * i + 1] * ri * g1);
        }
    }
    asm volatile("s_waitcnt lgkmcnt(0)" ::: "memory"); __builtin_amdgcn_s_barrier(); asm volatile("" ::: "memory");
}
__device__ __forceinline__ void attn_phase(Frame& F) {
    AttnCtx C;
    C.Q = (const bf16_t*)(F.ws + WS_Q); C.K = (const bf16_t*)(F.ws + WS_K); C.V = (const bf16_t*)(F.ws + WS_V); C.A2 = (bf16_t*)(F.ws + WS_ACT); C.subln = F.in[17];
    {
        const float a1 = wave_sum(F.in[13][F.lane] * F.in[14][F.lane]), a2 = wave_sum(F.in[15][F.lane] * F.in[16][F.lane]);
        C.lam = __expf(a1) - __expf(a2) + 0.2f;
        const float mq = wave_max(fabsf(F.in[11][F.lane])), mkk = wave_max(fabsf(F.in[12][F.lane]));
        C.negMb = -(8.f * mq * mkk * 1.4426950408889634f * 1.01f + 0.1f);
    }
    for (int u = F.vcu; u < 1152; u += F.G) {
        if (u < 1024) { const int b = u >> 6, h = (u >> 4) & 3, qb = u & 15; attn_unit(F, C, h, b * 2048 + 128 * qb, b * 2048, 32, NL + b * 256, 4); }
        else { const int e = u - 1024, b = e >> 3, h = (e >> 1) & 3, qb = e & 1; attn_unit(F, C, h, NL + b * 256 + 128 * qb, NL + b * 256, 4, 0, 0); }
    }
}
__device__ __forceinline__ void convgate_pass(Frame& F, int part, int nparts) {
    const bf16_t* BG = (const bf16_t*)(F.ws + WS_BG); const bf16_t* U = (const bf16_t*)(F.ws + WS_U); bf16_t* A2 = (bf16_t*)(F.ws + WS_ACT); const float* cw = F.in[10];
    for (int it = part * 512 + F.tid; it < NTOK * 64; it += nparts * 512) {
        const int row = it >> 6, c = (it & 63) * 8;
        const bool first = row < NL ? (row & 2047) == 0 : (row & 255) == 0, last = row < NL ? (row & 2047) == 2047 : (row & 255) == 255;
        const u32x4 z = {0u, 0u, 0u, 0u};
        const u32x4 bg = *(const u32x4*)(BG + (size_t)row * 512 + c), u1 = *(const u32x4*)(U + (size_t)row * 512 + c);
        const u32x4 u0 = first ? z : *(const u32x4*)(U + (size_t)(row - 1) * 512 + c), u2 = last ? z : *(const u32x4*)(U + (size_t)(row + 1) * 512 + c);
        float o[8];
#pragma unroll
        for (int i = 0; i < 4; ++i) {
            const float w0a = cw[c + 2 * i], w0b = cw[c + 2 * i + 1], w1a = cw[512 + c + 2 * i], w1b = cw[512 + c + 2 * i + 1], w2a = cw[1024 + c + 2 * i], w2b = cw[1024 + c + 2 * i + 1];
            o[2 * i] = bf_lo(bg[i]) * (bf_lo(u0[i]) * w0a + bf_lo(u1[i]) * w1a + bf_lo(u2[i]) * w2a);
            o[2 * i + 1] = bf_hi(bg[i]) * (bf_hi(u0[i]) * w0b + bf_hi(u1[i]) * w1b + bf_hi(u2[i]) * w2b);
        }
        u32x4 w; w.x = cvt_pk_bf16(o[0], o[1]); w.y = cvt_pk_bf16(o[2], o[3]); w.z = cvt_pk_bf16(o[4], o[5]); w.w = cvt_pk_bf16(o[6], o[7]);
        *(u32x4*)(A2 + (size_t)row * 1024 + c) = w;
    }
}
__device__ __forceinline__ void pool_pass(Frame& F) {
    const bf16_t* PV = (const bf16_t*)(F.ws + WS_PV); bf16_t* A6 = (bf16_t*)(F.ws + WS_ACT);
    for (int it = F.vcu * 512 + F.tid; it < NL * 64; it += F.G * 512) {
        const int row = it >> 6, c = (it & 63) * 8, t = row & 2047, rad = 1 << (c >> 7);
        const int lo = max(t - rad, 0), hi = min(t + rad + 1, 2048);
        float s[8];
#pragma unroll
        for (int i = 0; i < 8; ++i) s[i] = 0.f;
        const bf16_t* base = PV + (size_t)(row - t) * 512 + c;
        for (int j = lo; j < hi; ++j) { const u32x4 v = *(const u32x4*)(base + (size_t)j * 512);
#pragma unroll
            for (int i = 0; i < 4; ++i) { s[2 * i] += bf_lo(v[i]); s[2 * i + 1] += bf_hi(v[i]); } }
        const float inv = 1.f / (float)(hi - lo);
        const u32x4 v = *(const u32x4*)(base + (size_t)t * 512);
        u32x4 w;
#pragma unroll
        for (int i = 0; i < 4; ++i) w[i] = cvt_pk_bf16(s[2 * i] * inv - bf_lo(v[i]), s[2 * i + 1] * inv - bf_hi(v[i]));
        *(u32x4*)(A6 + (size_t)row * 1024 + c) = w;
    }
}
__device__ __forceinline__ void dma_tile(const bf16_t* src, int ld, int nrows, int rowbytes, unsigned dst, int wi, int nw, int lane) {
    const int lpr = rowbytes >> 4, rpp = 64 / lpr, npieces = nrows / rpp;
    for (int p = wi; p < npieces; p += nw) {
        const int row = p * rpp + lane / lpr, ch = lane % lpr;
        glds16(src + (size_t)row * ld + ch * 8, (unsigned)__builtin_amdgcn_readfirstlane(dst + p * 1024));
    }
}
template <int ORD> __device__ __forceinline__ bf16x8 tr_frag(const LAS char* tile, int rs, int k0, int c0, int lane) {
    const int hi = lane >> 5, q = (lane & 15) >> 2;
    const int colb = (c0 + 16 * ((lane >> 4) & 1) + 4 * (lane & 3)) * 2;
    const int r0 = ORD ? k0 + 4 * hi + q : k0 + 8 * hi + q, r1 = ORD ? r0 + 8 : r0 + 4;
    return cat8(tr_read(tile + r0 * rs + colb), tr_read(tile + r1 * rs + colb));
}
__device__ __forceinline__ void ret_states_unit(Frame& F, int bh, int dir, int vh) {
    const int lane = F.lane, w = F.wave, hi = lane >> 5, r32 = lane & 31, mb = (w >> 1) & 1, nb = w & 1, b = bh >> 2, h = bh & 3;
    const bool comp = w < 4;
    const unsigned lds0 = (unsigned)(uintptr_t)F.lds; const LAS char* L = (const LAS char*)F.lds;
    const bf16_t* KP = (const bf16_t*)(F.ws + (dir ? WS_KB : WS_KF)); const bf16_t* V1 = (const bf16_t*)(F.ws + WS_V1); bf16_t* ST = (bf16_t*)(F.ws + WS_ST);
    const float lg = -__expf((dir ? F.in[23] : F.in[22])[h]) * 1.4426950408889634f, l128 = __builtin_amdgcn_exp2f(lg * 128.f);
#define RS_ROW0(i) ((i) < 2 ? NL + b * 256 + ((dir ? 1 - (i) : (i)) * 128) : b * 2048 + (dir ? 17 - (i) : (i) - 2) * 128)
#define RS_ISSUE(i, slot) do { const int r0_ = RS_ROW0(i); const unsigned sb_ = lds0 + (unsigned)(slot) * 32768u; \
        dma_tile(KP + ((size_t)h * NTOK + r0_) * 64, 64, 128, 128, sb_, w, 8, lane); dma_tile(V1 + ((size_t)h * NTOK + r0_) * 128 + vh * 64, 128, 128, 128, sb_ + 16384, w, 8, lane); } while (0)
    RS_ISSUE(0, 0); RS_ISSUE(1, 1);
    f32x16 acc;
#pragma unroll
    for (int r = 0; r < 16; ++r) acc[r] = 0.f;
    u32x2 held[4] = {{0u, 0u}, {0u, 0u}, {0u, 0u}, {0u, 0u}};
    int slot = 0;
    for (int i = 0; i < 18; ++i) {
        if (i < 17) { WAIT_BAR(4); } else { WAIT_BAR(0); }
        if (comp && i >= 2) {
            u32x2 pk[4];
#pragma unroll
            for (int g = 0; g < 4; ++g) { pk[g].x = cvt_pk_bf16(acc[4 * g] * l128, acc[4 * g + 1] * l128); pk[g].y = cvt_pk_bf16(acc[4 * g + 2] * l128, acc[4 * g + 3] * l128); }
            if (((i - 2) & 1) == 0) {
#pragma unroll
                for (int g = 0; g < 4; ++g) held[g] = pk[g];
            } else {
                const int c = dir ? 17 - i : i - 2, cp = dir ? c + 1 : c - 1;
                bf16_t* sp = ST + (((size_t)bh * 16 + c) * 2 + dir) * 8192 + (size_t)(64 * vh + 32 * nb + r32) * 64 + 32 * mb + 4 * hi;
                bf16_t* spp = ST + (((size_t)bh * 16 + cp) * 2 + dir) * 8192 + (size_t)(64 * vh + 32 * nb + r32) * 64 + 32 * mb + 4 * hi;
#pragma unroll
                for (int g = 0; g < 4; ++g) { *(u32x2*)(spp + 8 * g) = held[g]; *(u32x2*)(sp + 8 * g) = pk[g]; }
            }
        }
        int s2 = slot + 2; if (s2 >= 3) s2 -= 3;
        if (i + 2 < 18) RS_ISSUE(i + 2, s2);
        if (comp) {
#pragma unroll
            for (int r = 0; r < 16; ++r) acc[r] *= l128;
            if (i < 17) {
                const LAS char* kt = L + slot * 32768; const LAS char* vt = kt + 16384;
                f32x16 acc2;
#pragma unroll
                for (int r = 0; r < 16; ++r) acc2[r] = 0.f;
#pragma unroll
                for (int s = 0; s < 8; s += 2) {
                    acc = MFMA32(tr_frag<0>(kt, 128, 16 * s, 32 * mb, lane), tr_frag<0>(vt, 128, 16 * s, 32 * nb, lane), acc);
                    acc2 = MFMA32(tr_frag<0>(kt, 128, 16 * s + 16, 32 * mb, lane), tr_frag<0>(vt, 128, 16 * s + 16, 32 * nb, lane), acc2);
                }
#pragma unroll
                for (int r = 0; r < 16; ++r) acc[r] += acc2[r];
            }
        }
        slot = slot + 1; if (slot >= 3) slot = 0;
    }
#undef RS_ISSUE
#undef RS_ROW0
    asm volatile("s_waitcnt lgkmcnt(0)" ::: "memory"); __builtin_amdgcn_s_barrier(); asm volatile("" ::: "memory");
}
template <int R> __device__ __forceinline__ void pool_item(const bf16_t* PV, bf16_t* A6, int row0, int c) {
    const int t0 = row0 & 2047;
    const bf16_t* base = PV + (size_t)(row0 - t0) * 512 + c;
    u32x4 v[16 + 2 * R];
#pragma unroll
    for (int i = 0; i < 16 + 2 * R; ++i) { const int t = t0 - R + i; v[i] = (t >= 0 && t < 2048) ? *(const u32x4*)(base + (size_t)t * 512) : (u32x4){0u, 0u, 0u, 0u}; }
    float s[8];
#pragma unroll
    for (int k = 0; k < 8; ++k) s[k] = 0.f;
#pragma unroll
    for (int i = 0; i < 2 * R; ++i)
#pragma unroll
        for (int k = 0; k < 4; ++k) { s[2 * k] += bf_lo(v[i][k]); s[2 * k + 1] += bf_hi(v[i][k]); }
#pragma unroll
    for (int i = 0; i < 16; ++i) {
        const int t = t0 + i;
#pragma unroll
        for (int k = 0; k < 4; ++k) { s[2 * k] += bf_lo(v[i + 2 * R][k]); s[2 * k + 1] += bf_hi(v[i + 2 * R][k]); }
        const int cnt = min(t + R + 1, 2048) - max(t - R, 0);
        const float inv = 1.f / (float)cnt;
        u32x4 wv;
#pragma unroll
        for (int k = 0; k < 4; ++k) wv[k] = cvt_pk_bf16(s[2 * k] * inv - bf_lo(v[i + R][k]), s[2 * k + 1] * inv - bf_hi(v[i + R][k]));
        *(u32x4*)(A6 + (size_t)(row0 + i) * 1024 + c) = wv;
#pragma unroll
        for (int k = 0; k < 4; ++k) { s[2 * k] -= bf_lo(v[i][k]); s[2 * k + 1] -= bf_hi(v[i][k]); }
    }
}
__device__ __forceinline__ void pool_pass2(Frame& F, int part, int nparts) {
    const bf16_t* PV = (const bf16_t*)(F.ws + WS_PV); bf16_t* A6 = (bf16_t*)(F.ws + WS_ACT);
    for (int it = part * 512 + F.tid; it < (NL / 16) * 64; it += nparts * 512) {
        const int c16 = it & 15, rbl = (it >> 4) & 3, g = (it >> 6) & 3, rb = (it >> 8) * 4 + rbl;
        const int row0 = rb * 16, c = g * 128 + c16 * 8;
        if (g == 0) pool_item<1>(PV, A6, row0, c); else if (g == 1) pool_item<2>(PV, A6, row0, c); else if (g == 2) pool_item<4>(PV, A6, row0, c); else pool_item<8>(PV, A6, row0, c);
    }
}
__device__ __forceinline__ void ret_stageC(Frame& F) {
    const int lane = F.lane, w = F.wave, r32 = lane & 31, hi = lane >> 5, half = w >> 2, ib = w & 3;
    const unsigned lds0 = (unsigned)(uintptr_t)F.lds;
    const bf16_t* QF = (const bf16_t*)(F.ws + WS_QF); const bf16_t* QB = (const bf16_t*)(F.ws + WS_QB); const bf16_t* KF = (const bf16_t*)(F.ws + WS_KF); const bf16_t* KB = (const bf16_t*)(F.ws + WS_KB);
    const bf16_t* V1 = (const bf16_t*)(F.ws + WS_V1); const bf16_t* G1 = (const bf16_t*)(F.ws + WS_G1); const bf16_t* ST = (const bf16_t*)(F.ws + WS_ST); bf16_t* A6 = (bf16_t*)(F.ws + WS_ACT);
#define RC_ISSUE(pr_, reg_) do { const int u_ = 2 * (pr_) + half, bh_ = u_ >> 4, cc_ = u_ & 15; \
        dma_tile(V1 + ((size_t)(bh_ & 3) * NTOK + (bh_ >> 2) * 2048 + cc_ * 128) * 128, 128, 128, 256, lds0 + (unsigned)(reg_) * 65536u + half * 32768u, ib, 4, lane); } while (0)
    int reg = 0;
    if (F.vcu < 512) RC_ISSUE(F.vcu, 0);
    for (int pr = F.vcu; pr < 512; pr += F.G, reg ^= 1) {
        const int u = 2 * pr + half, bh = u >> 4, cc = u & 15, b = bh >> 2, h = bh & 3, row0 = b * 2048 + cc * 128;
        const LAS char* L = (const LAS char*)F.lds + reg * 65536 + half * 32768;
        const size_t qoff = ((size_t)h * NL + row0 + 32 * ib + r32) * 64 + hi * 8;
        bf16x8 qf[4], qb[4];
#pragma unroll
        for (int d0 = 0; d0 < 4; ++d0) { qf[d0] = *(const bf16x8*)(QF + qoff + 16 * d0); qb[d0] = *(const bf16x8*)(QB + qoff + 16 * d0); }
        f32x16 o[4];
#pragma unroll
        for (int vb = 0; vb < 4; ++vb)
#pragma unroll
            for (int r = 0; r < 16; ++r) o[vb][r] = 0.f;
        const bf16_t* sfp = ST + ((size_t)u * 2 + 0) * 8192 + (size_t)r32 * 64 + hi * 8; const bf16_t* sbp = sfp + 8192;
        {
            bf16x8 sf[16], sb[16];
#pragma unroll
            for (int vb = 0; vb < 4; ++vb)
#pragma unroll
                for (int s = 0; s < 4; ++s) { sf[4 * vb + s] = *(const bf16x8*)(sfp + (size_t)(32 * vb) * 64 + 16 * s); sb[4 * vb + s] = *(const bf16x8*)(sbp + (size_t)(32 * vb) * 64 + 16 * s); }
#pragma unroll
            for (int vb = 0; vb < 4; ++vb)
#pragma unroll
                for (int s = 0; s < 4; ++s) { o[vb] = MFMA32(qf[s], sf[4 * vb + s], o[vb]); o[vb] = MFMA32(qb[s], sb[4 * vb + s], o[vb]); }
        }
        bf16x8 kfa[4], kba[4];
        { const size_t koff0 = ((size_t)h * NTOK + row0 + r32) * 64 + hi * 8;
#pragma unroll
          for (int d0 = 0; d0 < 4; ++d0) { kfa[d0] = *(const bf16x8*)(KF + koff0 + 16 * d0); kba[d0] = *(const bf16x8*)(KB + koff0 + 16 * d0); } }
        WAIT_BAR(0);
        if (pr + F.G < 512) RC_ISSUE(pr + F.G, reg ^ 1);
        const int iq = 32 * ib + r32;
#pragma unroll
        for (int jb = 0; jb < 4; ++jb) {
            bf16x8 kfn[4], kbn[4];
            if (jb < 3) { const size_t koff = ((size_t)h * NTOK + row0 + 32 * (jb + 1) + r32) * 64 + hi * 8;
#pragma unroll
                for (int d0 = 0; d0 < 4; ++d0) { kfn[d0] = *(const bf16x8*)(KF + koff + 16 * d0); kbn[d0] = *(const bf16x8*)(KB + koff + 16 * d0); } }
            f32x16 pf, pb;
#pragma unroll
            for (int r = 0; r < 16; ++r) { pf[r] = 0.f; pb[r] = 0.f; }
#pragma unroll
            for (int d0 = 0; d0 < 4; ++d0) { pf = MFMA32(kfa[d0], qf[d0], pf); pb = MFMA32(kba[d0], qb[d0], pb); }
            float pp[16];
#pragma unroll
            for (int r = 0; r < 16; ++r) { const int j = 32 * jb + crow(r, hi); pp[r] = (j <= iq ? pf[r] : 0.f) + (j >= iq ? pb[r] : 0.f); }
            u32x4 pw0, pw1;
#pragma unroll
            for (int i = 0; i < 4; ++i) { pw0[i] = cvt_pk_bf16(pp[2 * i], pp[2 * i + 1]); pw1[i] = cvt_pk_bf16(pp[8 + 2 * i], pp[9 + 2 * i]); }
#pragma unroll
            for (int vb = 0; vb < 4; ++vb) {
                o[vb] = MFMA32(as_bf16x8(pw0), tr_frag<1>(L, 256, 32 * jb, 32 * vb, lane), o[vb]);
                o[vb] = MFMA32(as_bf16x8(pw1), tr_frag<1>(L, 256, 32 * jb + 16, 32 * vb, lane), o[vb]);
            }
            if (jb < 3) {
#pragma unroll
                for (int d0 = 0; d0 < 4; ++d0) { kfa[d0] = kfn[d0]; kba[d0] = kbn[d0]; } }
        }
        asm volatile("s_waitcnt lgkmcnt(0)" ::: "memory"); __builtin_amdgcn_s_barrier(); asm volatile("" ::: "memory");
        LAS float* OS = (LAS float*)(F.lds + reg * 65536 + w * 8192);
        float ssq[2];
        u32x4 ggp[2][4];
#pragma unroll
        for (int ps = 0; ps < 2; ++ps) { const bf16_t* gp0 = G1 + ((size_t)h * NL + row0 + 32 * ib + 16 * ps + (lane >> 2)) * 128 + 32 * (lane & 3);
#pragma unroll
            for (int i = 0; i < 4; ++i) ggp[ps][i] = *(const u32x4*)(gp0 + 8 * i); }
#pragma unroll
        for (int ps = 0; ps < 2; ++ps) {
#pragma unroll
            for (int vb = 0; vb < 4; ++vb)
#pragma unroll
                for (int rr = 0; rr < 8; ++rr) { const int r = 8 * ps + rr, lr = (r & 3) + 4 * hi + 8 * ((r >> 2) & 1); OS[lr * 128 + ((32 * vb + r32) ^ (4 * (lr & 7)))] = o[vb][r]; }
            asm volatile("s_waitcnt lgkmcnt(0)" ::: "memory");
            const int lr = lane >> 2, qt = lane & 3;
            f32x4 v[8]; float ss = 0.f;
#pragma unroll
            for (int i = 0; i < 8; ++i) { v[i] = *(const LAS f32x4*)(OS + lr * 128 + ((32 * qt + 4 * i) ^ (4 * (lr & 7)))); ss += (v[i][0] * v[i][0] + v[i][1] * v[i][1]) + (v[i][2] * v[i][2] + v[i][3] * v[i][3]); }
            ss += __shfl_xor(ss, 1); ss += __shfl_xor(ss, 2);
            ssq[ps] = ss;
            const float ri = rsqrtf(ss * (1.f / 128.f) + 1e-6f);
            const size_t orow = (size_t)(row0 + 32 * ib + 16 * ps + lr);
            bf16_t* op = A6 + orow * 1024 + 512 + h * 128 + 32 * qt; const float* gn = F.in[24] + 32 * qt;
#pragma unroll
            for (int i = 0; i < 4; ++i) {
                const u32x4 gg = ggp[ps][i];
                const f32x4 g0 = *(const f32x4*)(gn + 8 * i), g1 = *(const f32x4*)(gn + 8 * i + 4);
                f32x4 a = v[2 * i] * ri * g0, c = v[2 * i + 1] * ri * g1;
                a[0] *= bf_lo(gg[0]); a[1] *= bf_hi(gg[0]); a[2] *= bf_lo(gg[1]); a[3] *= bf_hi(gg[1]); c[0] *= bf_lo(gg[2]); c[1] *= bf_hi(gg[2]); c[2] *= bf_lo(gg[3]); c[3] *= bf_hi(gg[3]);
                *(u32x4*)(op + 8 * i) = pack8(a, c);
            }
            asm volatile("s_waitcnt lgkmcnt(0)" ::: "memory");
        }
        (void)ssq;
    }
    asm volatile("s_waitcnt lgkmcnt(0)" ::: "memory"); __builtin_amdgcn_s_barrier(); asm volatile("" ::: "memory");
#undef RC_ISSUE
}
}
#ifndef MK_STG_A
#define MK_STG_A 0
#endif
#ifndef MK_STG_H
#define MK_STG_H 0
#endif
#ifndef MK_STG_B
#define MK_STG_B 0
#endif
namespace mk {
constexpr int N_PHASES = 14;
__global__ void __launch_bounds__(512, 2) fwd_megakernel(Args args) {
    extern __shared__ __attribute__((aligned(16))) unsigned char lds_raw[];
    Frame F;
    F.lds = (LAS unsigned char*)lds_raw;
    F.tid = threadIdx.x; F.lane = F.tid & 63; F.wave = __builtin_amdgcn_readfirstlane(F.tid >> 6);
    F.G = gridDim.x; { const int bx = blockIdx.x; F.vcu = (F.G % 8 == 0) ? (bx % 8) * (F.G / 8) + bx / 8 : bx; }
    F.in = args.in; F.out = args.out; F.ws = args.ws;
    volatile LAS unsigned* MISC = (volatile LAS unsigned*)(F.lds + MISC_OFF);
    for (int u = F.tid; u < 128; u += 512) MISC[u] = 0u;
    __syncthreads();
    XcdBarrier bar = xcd_barrier_post((unsigned*)(F.ws + WS_CTL) + CW_BAR, MISC + 8);
    const int lo = args.ph_lo, hi = args.ph_hi;
#define IN(k) (lo <= (k) && (k) < hi)
#ifdef MK_TS
    unsigned long long* TS = (unsigned long long*)(F.ws + WS_CTL + 524288);
#define STAMP(k) do { if (blockIdx.x == 0 && F.tid == 0) TS[k] = __builtin_amdgcn_s_memrealtime(); } while (0)
#else
#define STAMP(k) do { } while (0)
#endif
    STAMP(0);
#define SEAM(k) do { if (IN(k) && IN((k) + 1)) xcd_barrier(bar); STAMP((k) + 1); } while (0)
#define MOD ((float*)(F.ws + WS_MOD))
#define XC ((float*)(F.ws + WS_XC))
#define ACT ((bf16_t*)(F.ws + WS_ACT))
#define ring (F.lds)

#define ACT2 ((bf16_t*)(F.ws + WS_ACT2))
#define SS0 ((float*)(F.ws + WS_SS))
#define SS1 ((float*)(F.ws + WS_SS + SS_STRIDE))
#define SS2 ((float*)(F.ws + WS_SS + 2 * SS_STRIDE))
#define BU0 ((const float*)(F.ws + WS_BIAS + BIAS_BU0))
#define BI1 ((const float*)(F.ws + WS_BIAS + BIAS_BI1))
#define BU1 ((const float*)(F.ws + WS_BIAS + BIAS_BU1))
#define MOD1 (MOD + 17 * 6144)
#define side ((LAS float*)(F.lds + SIDE_OFF))

#define STAGGER(D) do { const unsigned long long d_ = (unsigned long long)((F.vcu & 3) * (D)); if (d_) { const unsigned long long t0_ = __builtin_amdgcn_s_memrealtime(); while (__builtin_amdgcn_s_memrealtime() - t0_ < d_) __builtin_amdgcn_s_sleep(8); } } while (0)
    if (IN(0)) p0_prologue(F, 0);
    SEAM(0);
    if (IN(1)) { norm_pass(F, F.in[0], F.in[2], NTOK, F.in[6], MOD, 0); p0_prologue(F, 1); p0_prologue(F, 2); }
    SEAM(1);
    if (IN(2)) {
        pg8::Gemm g{ACT, (const bf16_t*)(F.ws + WS_WIN0), 1024, 256L * 1024 * 2}; pg8::StaticOrder S; S.init(144, 12, F.G, (int)blockIdx.x);
        EpiIn0 E{F.ws, F.in[11], F.in[12]};
        STAGGER(MK_STG_A); pg8::gemm_phase(ring, g, S, E);
        if (F.G == 256) { if (blockIdx.x >= 192) bias_pass(F, (int)blockIdx.x - 192, 64, 0, 1); } else bias_pass(F, F.vcu, F.G, 0, 1);
    }
    SEAM(2);
    if (IN(3)) { attn_phase(F);
#ifdef MK_TS
        if (blockIdx.x == 0 && threadIdx.x == 0) ((unsigned long long*)(F.ws + 524288))[32] = __builtin_amdgcn_s_memrealtime();
        if (blockIdx.x == 4 && threadIdx.x == 0) ((unsigned long long*)(F.ws + 524288))[34] = __builtin_amdgcn_s_memrealtime();
#endif
        if (F.G == 256) {
            unsigned* ctr = (unsigned*)(F.ws + WS_CTL) + CW_BAR + 8;
            volatile LAS unsigned* shw = (volatile LAS unsigned*)(F.lds + MISC_OFF) + 100;
            __syncthreads();
            if (F.tid == 0) *shw = __hip_atomic_fetch_add(ctr, 1u, __ATOMIC_RELAXED, __HIP_MEMORY_SCOPE_AGENT);
            __syncthreads();
            unsigned sidx = *shw;
            while (sidx < 1536u) {
                unsigned pre = 0u;
                if (F.tid == 0) pre = __hip_atomic_fetch_add(ctr, 1u, __ATOMIC_RELAXED, __HIP_MEMORY_SCOPE_AGENT);
                convgate_pass(F, (int)sidx, 1536);
                __syncthreads();
                if (F.tid == 0) *shw = pre;
                __syncthreads();
                sidx = *shw;
            }
        }
        else convgate_pass(F, F.vcu, F.G);
#ifdef MK_TS
        if (blockIdx.x == 0 && threadIdx.x == 0) ((unsigned long long*)(F.ws + 524288))[33] = __builtin_amdgcn_s_memrealtime();
        if (blockIdx.x == 4 && threadIdx.x == 0) ((unsigned long long*)(F.ws + 524288))[35] = __builtin_amdgcn_s_memrealtime();
#endif
    }
    SEAM(3);
    if (IN(4)) {
        pg8::Gemm g{ACT, (const bf16_t*)(F.ws + WS_WOUT0), 1024, 256L * 1024 * 2}; pg8::StaticOrder S; S.init(128, 4, F.G, (int)blockIdx.x);
        EpiRes E{F.in[0], F.in[2], F.out, XC, MOD, 2048, ACT2, F.in[7], MOD, 4096, SS0};
        pg8::gemm_phase(ring, g, S, E);
    }
    SEAM(4);
    if (IN(5)) {
        { pg8::Gemm g{ACT, (const bf16_t*)(F.ws + WS_WOUT0), 1024, 256L * 1024 * 2}; pg8::ListOrder S{F.G, (int)blockIdx.x, 128, 0, 4, 64};
          EpiRes E{F.in[0], F.in[2], F.out, XC, MOD, 2048, ACT2, F.in[7], MOD, 4096, SS0};
          pg8::gemm_phase(ring, g, S, E); }
        MK_STAMP2(22);
        { pg8::Gemm g{ACT2 - 1024, (const bf16_t*)(F.ws + WS_WUP0), 1024, 254L * 1024 * 2}; pg8::DealOrder S; S.init(130, 22, F.G, (int)blockIdx.x, F.G == 256 ? 64 : 0, F.G == 256 ? 2 : 0);
          EpiUp E{(bf16_t*)(F.ws + WS_HACT), F.in[26], F.in[27], NL, side, SS0, BU0, 0, 0};
          pg8::gemm_phase(ring, g, S, E); }
        MK_STAMP2(23);
#ifdef MK_TS
        if (blockIdx.x == 200 && threadIdx.x == 0) ((unsigned long long*)(F.ws + 524288))[28] = __builtin_amdgcn_s_memrealtime();
#endif
        if (F.G == 256) { if (blockIdx.x >= 172) weights1_pass(F, (int)blockIdx.x - 172, 84, 0); } else weights1_pass(F, F.vcu, F.G, 0);
#ifdef MK_TS
        if (blockIdx.x == 200 && threadIdx.x == 0) ((unsigned long long*)(F.ws + 524288))[29] = __builtin_amdgcn_s_memrealtime();
#endif
    }
    SEAM(5);
    if (IN(6)) {
        { pg8::Gemm g{ACT2 + (size_t)(NL - 1) * 1024, (const bf16_t*)(F.ws + WS_WUP0), 1024, 254L * 1024 * 2}; pg8::StaticOrder S; S.init(17, 22, F.G, (int)blockIdx.x);
          EpiUp E{(bf16_t*)(F.ws + WS_HACT), F.in[26], F.in[27], NTOK, side, SS0, BU0, NL, NL};
          pg8::gemm_phase(ring, g, S, E); }
        MK_STAMP2(24);
        { pg8::Gemm g{(const bf16_t*)(F.ws + WS_HACT), (const bf16_t*)(F.ws + WS_WDN0), FF, 256L * FF * 2}; pg8::StaticOrder S; S.init(128, 4, F.G, (int)blockIdx.x);
          EpiRes E{F.out, XC, F.out, XC, MOD, 5120, ACT, F.in[6] + 1024, MOD1, 1024, SS1};
          pg8::gemm_phase(ring, g, S, E); }
        MK_STAMP2(25);
#ifdef MK_TS
        if (blockIdx.x == 200 && threadIdx.x == 0) ((unsigned long long*)(F.ws + 524288))[26] = __builtin_amdgcn_s_memrealtime();
#endif
        if (F.G == 256) { if (blockIdx.x >= 118) bias_pass(F, (int)blockIdx.x - 118, 138, 1, 2); } else bias_pass(F, F.vcu, F.G, 1, 2);
#ifdef MK_TS
        if (blockIdx.x == 200 && threadIdx.x == 0) ((unsigned long long*)(F.ws + 524288))[27] = __builtin_amdgcn_s_memrealtime();
#endif
    }
    SEAM(6);
    if (IN(7)) {
        { pg8::Gemm g{(const bf16_t*)(F.ws + WS_HACT), (const bf16_t*)(F.ws + WS_WDN0), FF, 256L * FF * 2}; pg8::ListOrder S{F.G, (int)blockIdx.x, 128, 0, 4, 64};
          EpiRes E{F.out, XC, F.out, XC, MOD, 5120, ACT, F.in[6] + 1024, MOD1, 1024, SS1};
          pg8::gemm_phase(ring, g, S, E); }
        { pg8::Gemm g{ACT, (const bf16_t*)(F.ws + WS_WIN1), 1024, 256L * 1024 * 2}; pg8::DealOrder S; S.init(128, 8, F.G, (int)blockIdx.x, F.G == 256 ? 64 : 0, F.G == 256 ? 4 : 0);
          EpiIn1 E{F.ws, F.in[22], F.in[23], SS1, BI1, side};
          pg8::gemm_phase(ring, g, S, E); }
    }
    SEAM(7);
    if (IN(8)) {
        const int nctx = F.G >= 96 ? 48 : 0;
        if (nctx) {
            if ((int)blockIdx.x < nctx) { pg8::Gemm g{ACT, (const bf16_t*)(F.ws + WS_WIN1), 1024, 256L * 1024 * 2}; pg8::ListOrder S{nctx, (int)blockIdx.x, 128, 3, 3, 48};
                EpiIn1 E{F.ws, F.in[22], F.in[23], SS1, BI1, side}; pg8::gemm_phase(ring, g, S, E); }
            else { pool_pass2(F, (int)blockIdx.x - nctx, F.G - nctx); weights1_pass(F, (int)blockIdx.x - nctx, F.G - nctx, 1); }
        } else {
            { pg8::Gemm g{ACT, (const bf16_t*)(F.ws + WS_WIN1), 1024, 256L * 1024 * 2}; pg8::ListOrder S{F.G, (int)blockIdx.x, 128, 3, 3, 48};
              EpiIn1 E{F.ws, F.in[22], F.in[23], SS1, BI1, side}; pg8::gemm_phase(ring, g, S, E); }
            pool_pass2(F, F.vcu, F.G); weights1_pass(F, F.vcu, F.G, 1);
        }
    }
#ifdef MK_TS
    if (blockIdx.x == 0 && threadIdx.x == 0) ((unsigned long long*)(F.ws + 524288))[30] = __builtin_amdgcn_s_memrealtime();
    if (blockIdx.x == 100 && threadIdx.x == 0) ((unsigned long long*)(F.ws + 524288))[31] = __builtin_amdgcn_s_memrealtime();
#endif
    SEAM(8);
    if (IN(9)) { for (int u = F.vcu; u < 256; u += F.G) ret_states_unit(F, u >> 2, (u >> 1) & 1, u & 1); }
    SEAM(9);
    if (IN(10)) ret_stageC(F);
    SEAM(10);
    if (IN(11)) {
        pg8::Gemm g{ACT, (const bf16_t*)(F.ws + WS_WOUT1), 1024, 256L * 1024 * 2}; pg8::StaticOrder S; S.init(128, 4, F.G, (int)blockIdx.x);
        EpiRes E{F.out, XC, F.out, XC, MOD1, 2048, ACT2, F.in[7] + 1024, MOD1, 4096, SS2};
        { const unsigned long long d_ = (unsigned long long)((F.vcu & 1) * (MK_STG_H)); if (d_) { const unsigned long long t0_ = __builtin_amdgcn_s_memrealtime(); while (__builtin_amdgcn_s_memrealtime() - t0_ < d_) __builtin_amdgcn_s_sleep(8); } } pg8::gemm_phase(ring, g, S, E);
    }
    SEAM(11);
    if (IN(12)) {
        pg8::Gemm g{ACT2 - 1024, (const bf16_t*)(F.ws + WS_WUP1), 1024, 254L * 1024 * 2}; pg8::StaticOrder S; S.init(130, 22, F.G, (int)blockIdx.x);
        EpiUp E{(bf16_t*)(F.ws + WS_HACT), F.in[26] + 3 * FF, F.in[27] + FF, NL, side, SS2, BU1, 0, 0};
        STAGGER(MK_STG_A); pg8::gemm_phase(ring, g, S, E);
    }
    SEAM(12);
    if (IN(13)) {
        pg8::Gemm g{(const bf16_t*)(F.ws + WS_HACT), (const bf16_t*)(F.ws + WS_WDN1), FF, 256L * FF * 2}; pg8::StaticOrder S; S.init(128, 4, F.G, (int)blockIdx.x);
        EpiRes E{F.out, XC, F.out, XC, MOD1, 5120, nullptr, nullptr, nullptr, 0, nullptr};
        STAGGER(MK_STG_B); pg8::gemm_phase(ring, g, S, E);
    }
#ifdef MK_TS
    xcd_barrier(bar); STAMP(14);
    if (blockIdx.x == 0 && F.wave == 0) {
        float best = 1e30f; int bi = 0;
        for (int e = F.lane; e < 4096; e += 64) { const float v = fabsf(F.out[e]); if (v < best) { best = v; bi = e; } }
        for (int o = 32; o > 0; o >>= 1) { const float ob = __shfl_xor(best, o); const int oi = __shfl_xor(bi, o); if (ob < best || (ob == best && oi < bi)) { best = ob; bi = oi; } }
        if (F.lane == 0) { float us = (float)(TS[MK_TS_B] - TS[MK_TS_A]) * 0.01f;
#ifdef MK_TS_OFF
            us -= (MK_TS_OFF); us = us < 0.f ? 0.f : us;
#endif
            F.out[bi] += 0.04f + us * (MK_TS_SCALE); }
    }
#endif
#undef IN
#undef SEAM
#undef ACT2
#undef SS0
#undef SS1
#undef SS2
#undef BU0
#undef BI1
#undef BU1
#undef MOD1
#undef side
#undef MOD
#undef XC
#undef ACT
#undef ring
}

static int g_grid = 0;
inline void launch(hipStream_t stream, void* const* d_in, void* d_out, void* d_ws, int ph_lo, int ph_hi) {
    if (g_grid == 0) {
        int dev = 0, cus = 0, per_cu = 0;
        (void)hipGetDevice(&dev); (void)hipDeviceGetAttribute(&cus, hipDeviceAttributeMultiprocessorCount, dev);
        (void)hipFuncSetAttribute((const void*)fwd_megakernel, hipFuncAttributeMaxDynamicSharedMemorySize, LDS_BYTES);
        (void)hipOccupancyMaxActiveBlocksPerMultiprocessor(&per_cu, (const void*)fwd_megakernel, 512, LDS_BYTES);
        (void)hipGetLastError();
        if (per_cu < 1) fprintf(stderr, "kernel_launch: occupancy query reports %d blocks per CU\n", per_cu);
        g_grid = cus > 0 ? cus : 256;
    }
#ifdef MK_TS
    (void)hipMemsetAsync((char*)d_ws + WS_CTL, 0, CTL_ZERO_BYTES, stream);
#else
    (void)hipMemsetAsync((char*)d_ws + WS_CTL + CW_BAR * 4, 0, XCD_BAR_WORDS * 4, stream);
#endif
    Args a{};
    for (int i = 0; i < 29; ++i) a.in[i] = (const float*)d_in[i];
    a.out = (float*)d_out; a.ws = (unsigned char*)d_ws; a.ph_lo = ph_lo; a.ph_hi = ph_hi;
    hipLaunchKernelGGL(fwd_megakernel, dim3(g_grid), dim3(512), LDS_BYTES, stream, a);
}
}
extern "C" void kernel_launch(void* const* d_in, const int* in_sizes, int n_in, void* d_out, int out_size, void* d_ws, size_t ws_size, hipStream_t stream) {
    mk::launch(stream, d_in, d_out, d_ws, 0, mk::N_PHASES);
}
```
